# Optimizing an MI355X kernel written in HIP

```python
import math
import jax, jax.numpy as jnp
from jax import lax
import numpy as np

D_MODEL = 1024
BATCH = 8
SEQ = 4096
DEPTH = 4

N_MEM = 256
N_Q_HEADS = 8
N_KV_HEADS = 2
HEAD_DIM = 64
Q_GROUP = N_Q_HEADS // N_KV_HEADS
WINDOW = 128
BLOCK = 128
ROT_DIM = HEAD_DIM // 4
ROPE_THETA = 500000.0
SSM_WIDTH = D_MODEL // 2
SSM_GROUP = 16
SSM_GROUPS = SSM_WIDTH // SSM_GROUP
SSM_STATE = 64
POOL_WINDOWS = (2, 4, 8, 16)
POOL_WIDTH = D_MODEL // 2
POOL_GROUP = POOL_WIDTH // len(POOL_WINDOWS)
X_HEADS = 4
X_HEAD_DIM = D_MODEL // X_HEADS
D_FF = 2816
N_EXPERTS = 8
TOP_K = 2
D_FF_EXPERT = 3584
N_BRANCHES = 3
Q_WIDTH = N_Q_HEADS * HEAD_DIM
KV_WIDTH = N_KV_HEADS * HEAD_DIM
ATTN_WIDTH = Q_WIDTH
SPLITS = (Q_WIDTH, Q_WIDTH + KV_WIDTH, Q_WIDTH + 2 * KV_WIDTH, Q_WIDTH + 2 * KV_WIDTH + SSM_WIDTH, Q_WIDTH + 2 * KV_WIDTH + SSM_WIDTH + POOL_WIDTH)
IN_WIDTH = SPLITS[-1] + N_BRANCHES * D_MODEL
DN_ALPHA = (2.0 * DEPTH) ** 0.25
DN_BETA = (8.0 * DEPTH) ** -0.25
N_DENSE = (DEPTH + 1) // 2
N_MOE = DEPTH // 2
LN_EPS = 1e-5
NEG_INF = -1e30

kernel_name = 'hybrid_gated_swa_s5_pool_moe_block'


def layer_norm(x, g, b):
    xf = x.astype(jnp.float32)
    mu = jnp.mean(xf, axis=-1, keepdims=True)
    var = jnp.mean(jnp.square(xf - mu), axis=-1, keepdims=True)
    y = (xf - mu) * lax.rsqrt(var + LN_EPS)
    return (y * g.astype(jnp.float32) + b.astype(jnp.float32)).astype(x.dtype)


def partial_rotary(t, pos):
    half = ROT_DIM // 2
    inv_freq = jnp.power(jnp.float32(ROPE_THETA), -jnp.arange(half, dtype=jnp.float32) / half)
    ang = pos.astype(jnp.float32)[:, None] * inv_freq[None, :]
    cos = jnp.cos(ang)[None, :, None, :]
    sin = jnp.sin(ang)[None, :, None, :]
    tr = t[..., :ROT_DIM].astype(jnp.float32)
    t1, t2 = tr[..., :half], tr[..., half:]
    rot = jnp.concatenate([t1 * cos - t2 * sin, t2 * cos + t1 * sin], axis=-1)
    return jnp.concatenate([rot.astype(t.dtype), t[..., ROT_DIM:]], axis=-1)


def sliding_window_attention(q, k, v, sinks):
    bsz, l = q.shape[0], q.shape[1]
    nb = l // BLOCK
    qb = q.reshape(bsz, nb, BLOCK, N_KV_HEADS, Q_GROUP, HEAD_DIM)
    kb = k.reshape(bsz, nb, BLOCK, N_KV_HEADS, HEAD_DIM)
    vb = v.reshape(bsz, nb, BLOCK, N_KV_HEADS, HEAD_DIM)

    def with_prev_block(t):
        prev = jnp.pad(t, ((0, 0), (1, 0), (0, 0), (0, 0), (0, 0)))[:, :nb]
        return jnp.concatenate([prev, t], axis=2)

    kw, vw = with_prev_block(kb), with_prev_block(vb)
    s = jnp.einsum('bnqkgd,bnskd->bnkgqs', qb, kw).astype(jnp.float32) * (HEAD_DIM ** -0.5)
    qi = jnp.arange(BLOCK)[:, None]
    si = jnp.arange(2 * BLOCK)[None, :]
    rel = qi + BLOCK - si
    band = (rel >= 0) & (rel < WINDOW)
    has_prev = (jnp.arange(nb)[:, None] > 0) | (si >= BLOCK)
    mask = band[None, :, :] & has_prev[:, None, :]
    s = jnp.where(mask[None, :, None, None], s, NEG_INF)
    sink = sinks.astype(jnp.float32).reshape(N_KV_HEADS, Q_GROUP)[None, None, :, :, None, None]
    m = jnp.maximum(jnp.max(s, axis=-1, keepdims=True), sink)
    p = jnp.exp(s - m)
    p = p / (jnp.sum(p, axis=-1, keepdims=True) + jnp.exp(sink - m))
    o = jnp.einsum('bnkgqs,bnskd->bnqkgd', p.astype(v.dtype), vw)
    return o.reshape(bsz, l, N_Q_HEADS * HEAD_DIM)


def _complex_linear_combine(e1, e2):
    a1r, a1i, b1r, b1i = e1
    a2r, a2i, b2r, b2i = e2
    return (a2r * a1r - a2i * a1i, a2r * a1i + a2i * a1r,
            a2r * b1r - a2i * b1i + b2r, a2r * b1i + a2i * b1r + b2i)


def s5_ssm(u, a_re, a_im, log_dt, b_re, b_im, c_re, c_im, d_skip):
    bsz, l = u.shape[0], u.shape[1]
    f32 = jnp.float32
    uf = u.astype(f32).reshape(bsz, l, SSM_GROUPS, SSM_GROUP)
    ar, ai = a_re.astype(f32), a_im.astype(f32)
    dt = jnp.exp(log_dt.astype(f32))[:, None]
    decay = jnp.exp(dt * ar)
    abar_re, abar_im = decay * jnp.cos(dt * ai), decay * jnp.sin(dt * ai)
    inv_abs2 = 1.0 / (ar * ar + ai * ai)
    num_re, num_im = abar_re - 1.0, abar_im
    f_re = (num_re * ar + num_im * ai) * inv_abs2
    f_im = (num_im * ar - num_re * ai) * inv_abs2
    br, bi = b_re.astype(f32), b_im.astype(f32)
    bbar_re = f_re[..., None] * br - f_im[..., None] * bi
    bbar_im = f_re[..., None] * bi + f_im[..., None] * br
    bu_re = jnp.einsum('blgp,gnp->blgn', uf, bbar_re)
    bu_im = jnp.einsum('blgp,gnp->blgn', uf, bbar_im)
    a_seq_re = jnp.broadcast_to(abar_re[None, None], (1, l, SSM_GROUPS, SSM_STATE))
    a_seq_im = jnp.broadcast_to(abar_im[None, None], (1, l, SSM_GROUPS, SSM_STATE))
    _, _, s_re, s_im = lax.associative_scan(_complex_linear_combine, (a_seq_re, a_seq_im, bu_re, bu_im), axis=1)
    y = jnp.einsum('blgn,gpn->blgp', s_re, c_re.astype(f32)) - jnp.einsum('blgn,gpn->blgp', s_im, c_im.astype(f32))
    y = y + d_skip.astype(f32).reshape(SSM_GROUPS, SSM_GROUP) * uf
    return y.reshape(bsz, l, SSM_WIDTH)


def glu_after_gelu(y, w_glu, dtype):
    h = jax.nn.gelu(y).astype(dtype)
    hv, hg = jnp.split(h @ w_glu, 2, axis=-1)
    return hv * jax.nn.sigmoid(hg)


def multiscale_pool(u, pool_w, pool_scale):
    bsz, l = u.shape[0], u.shape[1]
    uf = u.astype(jnp.float32).reshape(bsz, l, len(POOL_WINDOWS), POOL_GROUP)
    cs = jnp.cumsum(uf, axis=1)
    pos1 = jnp.arange(1, l + 1, dtype=jnp.int32)
    outs = []
    for gi, w in enumerate(POOL_WINDOWS):
        csg = cs[:, :, gi]
        prev = jnp.pad(csg[:, :l - w], ((0, 0), (w, 0), (0, 0)))
        count = jnp.minimum(pos1, w).astype(jnp.float32)[None, :, None]
        outs.append((csg - prev) / count - uf[:, :, gi])
    pooled = jnp.stack(outs, axis=2)
    mixed = jnp.einsum('blgc,gcd->blgd', pooled.astype(u.dtype), pool_w)
    return mixed.reshape(bsz, l, POOL_WIDTH) * pool_scale


def hybrid_mixer(x, pos, w_in, b_gate, sinks, a_re, a_im, log_dt, b_re, b_im, c_re, c_im, d_skip, w_glu,
                 pool_w, pool_scale, w_br_attn, w_br_ssm, w_br_pool, w_o):
    bsz, l = x.shape[0], x.shape[1]
    proj = x @ w_in
    q, k, v, u_ssm, u_pool, gate_logits = jnp.split(proj, list(SPLITS), axis=-1)
    q = partial_rotary(q.reshape(bsz, l, N_Q_HEADS, HEAD_DIM), pos)
    k = partial_rotary(k.reshape(bsz, l, N_KV_HEADS, HEAD_DIM), pos)
    v = v.reshape(bsz, l, N_KV_HEADS, HEAD_DIM)
    attn_out = sliding_window_attention(q, k, v, sinks) @ w_br_attn
    ssm_out = glu_after_gelu(s5_ssm(u_ssm, a_re, a_im, log_dt, b_re, b_im, c_re, c_im, d_skip), w_glu, x.dtype) @ w_br_ssm
    pool_out = multiscale_pool(u_pool, pool_w, pool_scale) @ w_br_pool
    gates = jax.nn.sigmoid(gate_logits + b_gate).reshape(bsz, l, N_BRANCHES, D_MODEL)
    merged = gates[:, :, 0] * attn_out + gates[:, :, 1] * ssm_out + gates[:, :, 2] * pool_out
    return merged @ w_o


def memory_cross_attention(x, mem, wq, wkv, wo):
    bsz, l = x.shape[0], x.shape[1]
    m = mem.shape[1]
    q = (x @ wq).reshape(bsz, l, X_HEADS, X_HEAD_DIM)
    kk, vv = jnp.split(mem @ wkv, 2, axis=-1)
    kk = kk.reshape(bsz, m, X_HEADS, X_HEAD_DIM)
    vv = vv.reshape(bsz, m, X_HEADS, X_HEAD_DIM)
    s = jnp.einsum('blhd,bmhd->bhlm', q, kk).astype(jnp.float32) * (X_HEAD_DIM ** -0.5)
    p = jax.nn.softmax(s, axis=-1).astype(x.dtype)
    o = jnp.einsum('bhlm,bmhd->blhd', p, vv).reshape(bsz, l, D_MODEL)
    return o @ wo


def swiglu(x, w_gu, w_down):
    gt, up = jnp.split(x @ w_gu, 2, axis=-1)
    return (jax.nn.silu(gt) * up) @ w_down


def moe_swiglu(x, w_router, b_router, w_gu, w_down):
    logits = (x @ w_router).astype(jnp.float32) + b_router.astype(jnp.float32)
    top_vals, top_idx = lax.top_k(logits, TOP_K)
    top_w = jax.nn.softmax(top_vals, axis=-1)
    combine = jnp.sum(jax.nn.one_hot(top_idx, N_EXPERTS, dtype=jnp.float32) * top_w[..., None], axis=-2)
    out = jnp.zeros_like(x)
    for e in range(N_EXPERTS):
        out = out + combine[..., e:e + 1].astype(x.dtype) * swiglu(x, w_gu[e], w_down[e])
    return out


def setup_inputs(seed: int = 0) -> dict:
    key = jax.random.key(seed)
    ks = jax.random.split(key, 40)

    def nrm(i, shape, scale):
        return jax.random.normal(ks[i], shape, jnp.float32) * scale

    L = DEPTH
    G, N, P = SSM_GROUPS, SSM_STATE, SSM_GROUP
    a_im_base = jnp.pi * jnp.arange(N, dtype=jnp.float32)
    return {
        'x': nrm(0, (BATCH, SEQ, D_MODEL), 1.0),
        'mem': nrm(1, (BATCH, N_MEM, D_MODEL), 1.0),
        'w_in': nrm(2, (L, D_MODEL, IN_WIDTH), D_MODEL ** -0.5),
        'b_gate': nrm(3, (L, N_BRANCHES * D_MODEL), 0.02),
        'attn_sinks': nrm(4, (L, N_Q_HEADS), 0.5),
        'ssm_a_re': -0.5 + nrm(5, (L, G, N), 0.02),
        'ssm_a_im': a_im_base + nrm(6, (L, G, N), 0.02),
        'ssm_log_dt': jax.random.uniform(ks[7], (L, G), jnp.float32, math.log(1e-3), math.log(1e-1)),
        'ssm_b_re': nrm(8, (L, G, N, P), (2.0 * P) ** -0.5),
        'ssm_b_im': nrm(9, (L, G, N, P), (2.0 * P) ** -0.5),
        'ssm_c_re': nrm(10, (L, G, P, N), N ** -0.5),
        'ssm_c_im': nrm(11, (L, G, P, N), N ** -0.5),
        'ssm_d': nrm(12, (L, SSM_WIDTH), 0.5),
        'ssm_w_glu': nrm(13, (L, SSM_WIDTH, 2 * SSM_WIDTH), SSM_WIDTH ** -0.5),
        'pool_w': nrm(14, (L, len(POOL_WINDOWS), POOL_GROUP, POOL_GROUP), POOL_GROUP ** -0.5),
        'pool_scale': 1.0 + nrm(15, (L, POOL_WIDTH), 0.02),
        'w_br_attn': nrm(16, (L, ATTN_WIDTH, D_MODEL), ATTN_WIDTH ** -0.5),
        'w_br_ssm': nrm(17, (L, SSM_WIDTH, D_MODEL), SSM_WIDTH ** -0.5),
        'w_br_pool': nrm(18, (L, POOL_WIDTH, D_MODEL), POOL_WIDTH ** -0.5),
        'w_o': nrm(19, (L, D_MODEL, D_MODEL), D_MODEL ** -0.5 * DN_BETA),
        'ln1_g': 1.0 + nrm(20, (L, D_MODEL), 0.02),
        'ln1_b': nrm(21, (L, D_MODEL), 0.02),
        'xa_wq': nrm(22, (L, D_MODEL, D_MODEL), D_MODEL ** -0.5),
        'xa_wkv': nrm(23, (L, D_MODEL, 2 * D_MODEL), D_MODEL ** -0.5),
        'xa_wo': nrm(24, (L, D_MODEL, D_MODEL), D_MODEL ** -0.5 * DN_BETA),
        'ln2_g': 1.0 + nrm(25, (L, D_MODEL), 0.02),
        'ln2_b': nrm(26, (L, D_MODEL), 0.02),
        'ffn_w_gu': nrm(27, (N_DENSE, D_MODEL, 2 * D_FF), D_MODEL ** -0.5),
        'ffn_w_down': nrm(28, (N_DENSE, D_FF, D_MODEL), D_FF ** -0.5 * DN_BETA),
        'moe_w_router': nrm(29, (N_MOE, D_MODEL, N_EXPERTS), D_MODEL ** -0.5),
        'moe_b_router': nrm(30, (N_MOE, N_EXPERTS), 0.01),
        'moe_w_gu': nrm(31, (N_MOE, N_EXPERTS, D_MODEL, 2 * D_FF_EXPERT), D_MODEL ** -0.5),
        'moe_w_down': nrm(32, (N_MOE, N_EXPERTS, D_FF_EXPERT, D_MODEL), D_FF_EXPERT ** -0.5 * DN_BETA),
        'ln3_g': 1.0 + nrm(33, (L, D_MODEL), 0.02),
        'ln3_b': nrm(34, (L, D_MODEL), 0.02),
    }


def reference(x, mem, w_in, b_gate, attn_sinks, ssm_a_re, ssm_a_im, ssm_log_dt, ssm_b_re, ssm_b_im,
              ssm_c_re, ssm_c_im, ssm_d, ssm_w_glu, pool_w, pool_scale, w_br_attn, w_br_ssm, w_br_pool, w_o,
              ln1_g, ln1_b, xa_wq, xa_wkv, xa_wo, ln2_g, ln2_b, ffn_w_gu, ffn_w_down,
              moe_w_router, moe_b_router, moe_w_gu, moe_w_down, ln3_g, ln3_b):
    pos = jnp.arange(x.shape[1], dtype=jnp.int32)
    for i in range(DEPTH):
        h = hybrid_mixer(x, pos, w_in[i], b_gate[i], attn_sinks[i], ssm_a_re[i], ssm_a_im[i], ssm_log_dt[i],
                         ssm_b_re[i], ssm_b_im[i], ssm_c_re[i], ssm_c_im[i], ssm_d[i], ssm_w_glu[i],
                         pool_w[i], pool_scale[i], w_br_attn[i], w_br_ssm[i], w_br_pool[i], w_o[i])
        x = layer_norm(DN_ALPHA * x + h, ln1_g[i], ln1_b[i])
        c = memory_cross_attention(x, mem, xa_wq[i], xa_wkv[i], xa_wo[i])
        x = layer_norm(DN_ALPHA * x + c, ln2_g[i], ln2_b[i])
        j = i // 2
        if i % 2 == 0:
            f = swiglu(x, ffn_w_gu[j], ffn_w_down[j])
        else:
            f = moe_swiglu(x, moe_w_router[j], moe_b_router[j], moe_w_gu[j], moe_w_down[j])
        x = layer_norm(DN_ALPHA * x + f, ln3_g[i], ln3_b[i])
    return x
```

```cpp
#include <hip/hip_runtime.h>
#include <cstdio>
#include <cstdint>
#include <cstring>
namespace nv {
constexpr int SEQ = 4096, DM = 1024, INW = 4864;
constexpr int OFF_Q = 0, OFF_K = 512, OFF_V = 640, OFF_SSM = 768, OFF_POOL = 1280, OFF_GATE = 1792;
constexpr float DN_ALPHA = 1.681792830507429f;
constexpr float LN_EPS = 1e-5f;

struct GemmP {
    const float* A; const float* B; const float* B2; float* C;
    const int* rowidx; const int* mptr; const int* orow; const float* oscale;
    long long sA1, sA2, sB1, sB2, sC1, sC2;
    int M, N, K, lda, ldb, ldc, zdiv, accum;
    float alpha; int pad;
};

template <bool TRANSB, bool DUAL>
__global__ __launch_bounds__(256) void gemm_k(GemmP p) {
    __shared__ float As[16][132];
    __shared__ float Bs[16][132];
    __shared__ float Bs2[DUAL ? 16 : 1][132];
    const int tid = threadIdx.x, tx = tid & 15, ty = tid >> 4;
    const int z = blockIdx.z, zq = z / p.zdiv, zr = z % p.zdiv;
    const float* A = p.A + zq * p.sA1 + zr * p.sA2;
    const float* B = p.B + zq * p.sB1 + zr * p.sB2;
    const float* B2 = DUAL ? (p.B2 + zq * p.sB1 + zr * p.sB2) : nullptr;
    float* C = p.C + zq * p.sC1 + zr * p.sC2;
    const int M = p.mptr ? *p.mptr : p.M;
    const int m0 = blockIdx.y * 128, n0 = blockIdx.x * 128;
    if (m0 >= M) return;
    const float* aptr[2]; bool aval[2]; int ar[2], akq[2];
#pragma unroll
    for (int i = 0; i < 2; ++i) {
        const int idx = tid + i * 256; ar[i] = idx >> 2; akq[i] = idx & 3;
        const int gr = m0 + ar[i]; aval[i] = gr < M;
        const int src = aval[i] ? (p.rowidx ? p.rowidx[gr] : gr) : 0;
        aptr[i] = A + (long long)src * p.lda + akq[i] * 4;
    }
    float acc[8][8], acc2[8][8];
#pragma unroll
    for (int i = 0; i < 8; ++i)
#pragma unroll
        for (int j = 0; j < 8; ++j) { acc[i][j] = 0.f; acc2[i][j] = 0.f; }
    for (int k0 = 0; k0 < p.K; k0 += 16) {
#pragma unroll
        for (int i = 0; i < 2; ++i) {
            float4 v = aval[i] ? *(const float4*)(aptr[i] + k0) : make_float4(0.f, 0.f, 0.f, 0.f);
            As[akq[i] * 4 + 0][ar[i]] = v.x; As[akq[i] * 4 + 1][ar[i]] = v.y; As[akq[i] * 4 + 2][ar[i]] = v.z; As[akq[i] * 4 + 3][ar[i]] = v.w;
        }
        if (TRANSB) {
#pragma unroll
            for (int i = 0; i < 2; ++i) {
                const int idx = tid + i * 256, r = idx >> 2, kq = idx & 3;
                float4 v = *(const float4*)(B + (long long)(n0 + r) * p.ldb + k0 + kq * 4);
                Bs[kq * 4 + 0][r] = v.x; Bs[kq * 4 + 1][r] = v.y; Bs[kq * 4 + 2][r] = v.z; Bs[kq * 4 + 3][r] = v.w;
            }
        } else {
#pragma unroll
            for (int i = 0; i < 2; ++i) {
                const int idx = tid + i * 256, kk = idx >> 5, nq = idx & 31;
                *(float4*)&Bs[kk][nq * 4] = *(const float4*)(B + (long long)(k0 + kk) * p.ldb + n0 + nq * 4);
                if constexpr (DUAL) *(float4*)&Bs2[kk][nq * 4] = *(const float4*)(B2 + (long long)(k0 + kk) * p.ldb + n0 + nq * 4);
            }
        }
        __syncthreads();
#pragma unroll
        for (int kk = 0; kk < 16; ++kk) {
            float a[8], b[8], b2[8] = {0.f, 0.f, 0.f, 0.f, 0.f, 0.f, 0.f, 0.f};
            const float4 a0 = *(const float4*)&As[kk][ty * 4], a1 = *(const float4*)&As[kk][64 + ty * 4];
            const float4 b0 = *(const float4*)&Bs[kk][tx * 4], b1 = *(const float4*)&Bs[kk][64 + tx * 4];
            a[0] = a0.x; a[1] = a0.y; a[2] = a0.z; a[3] = a0.w; a[4] = a1.x; a[5] = a1.y; a[6] = a1.z; a[7] = a1.w;
            b[0] = b0.x; b[1] = b0.y; b[2] = b0.z; b[3] = b0.w; b[4] = b1.x; b[5] = b1.y; b[6] = b1.z; b[7] = b1.w;
            if constexpr (DUAL) { const float4 c0 = *(const float4*)&Bs2[kk][tx * 4], c1 = *(const float4*)&Bs2[kk][64 + tx * 4];
                b2[0] = c0.x; b2[1] = c0.y; b2[2] = c0.z; b2[3] = c0.w; b2[4] = c1.x; b2[5] = c1.y; b2[6] = c1.z; b2[7] = c1.w; }
#pragma unroll
            for (int i = 0; i < 8; ++i)
#pragma unroll
                for (int j = 0; j < 8; ++j) { acc[i][j] = fmaf(a[i], b[j], acc[i][j]); if constexpr (DUAL) acc2[i][j] = fmaf(a[i], b2[j], acc2[i][j]); }
        }
        __syncthreads();
    }
#pragma unroll
    for (int i = 0; i < 8; ++i) {
        const int gr = m0 + (i < 4 ? ty * 4 + i : 64 + ty * 4 + i - 4);
        if (gr >= M) continue;
        const int orow = p.orow ? p.orow[gr] : gr;
        const float sc = p.alpha * (p.oscale ? p.oscale[gr] : 1.f);
        float* cp = C + (long long)orow * p.ldc + n0;
#pragma unroll
        for (int jh = 0; jh < 2; ++jh) {
            float4 o; float* op = cp + jh * 64 + tx * 4;
            float v[4];
#pragma unroll
            for (int j = 0; j < 4; ++j) { float x = acc[i][jh * 4 + j]; if constexpr (DUAL) { const float u = acc2[i][jh * 4 + j]; x = x / (1.f + expf(-x)) * u; } v[j] = x * sc; }
            if (p.accum) { const float4 old = *(const float4*)op; v[0] += old.x; v[1] += old.y; v[2] += old.z; v[3] += old.w; }
            o.x = v[0]; o.y = v[1]; o.z = v[2]; o.w = v[3];
            *(float4*)op = o;
        }
    }
}

__device__ __forceinline__ float wsum(float v) {
#pragma unroll
    for (int o = 1; o < 64; o <<= 1) v += __shfl_xor(v, o);
    return v;
}
__device__ __forceinline__ float wmax(float v) {
#pragma unroll
    for (int o = 1; o < 64; o <<= 1) v = fmaxf(v, __shfl_xor(v, o));
    return v;
}
__device__ __forceinline__ float sigmoidf_(float x) { return 1.f / (1.f + expf(-x)); }
__device__ __forceinline__ float gelu_tanh(float x) { return 0.5f * x * (1.f + tanhf(0.7978845608028654f * (x + 0.044715f * x * x * x))); }

__global__ void rotary_k(float* proj, int R) {
    const long long n = (long long)R * 80;
    for (long long idx = (long long)blockIdx.x * blockDim.x + threadIdx.x; idx < n; idx += (long long)gridDim.x * blockDim.x) {
        const int row = (int)(idx / 80), rem = (int)(idx % 80), hh = rem >> 3, i = rem & 7;
        const int base = hh < 8 ? hh * 64 : OFF_K + (hh - 8) * 64;
        const float pos = (float)(row % SEQ);
        const float inv = powf(500000.0f, -(float)i / 8.0f);
        const float ang = pos * inv; float sn, cs; sincosf(ang, &sn, &cs);
        float* p = proj + (long long)row * INW + base;
        const float t1 = p[i], t2 = p[8 + i];
        p[i] = t1 * cs - t2 * sn; p[8 + i] = t2 * cs + t1 * sn;
    }
}
__global__ void swa_k(const float* proj, const float* sinks, float* out, int R) {
    const int lane = threadIdx.x & 63; const long long wid0 = ((long long)blockIdx.x * blockDim.x + threadIdx.x) >> 6, nw = ((long long)gridDim.x * blockDim.x) >> 6;
    for (long long w = wid0; w < (long long)R * 8; w += nw) {
        const int row = (int)(w >> 3), h = (int)(w & 7), kvh = h >> 2, t = row % SEQ;
        const float q = proj[(long long)row * INW + OFF_Q + h * 64 + lane];
        float m = sinks[h], l = 1.f, acc = 0.f;
        const int s0 = t - 127 < 0 ? 0 : t - 127;
        for (int s = s0; s <= t; ++s) {
            const long long kr = (long long)(row - (t - s)) * INW;
            const float kd = proj[kr + OFF_K + kvh * 64 + lane], vd = proj[kr + OFF_V + kvh * 64 + lane];
            const float sc = wsum(q * kd) * 0.125f;
            const float mn = fmaxf(m, sc), scl = expf(m - mn), pe = expf(sc - mn);
            l = l * scl + pe; acc = acc * scl + pe * vd; m = mn;
        }
        out[(long long)row * 512 + h * 64 + lane] = acc / l;
    }
}
__global__ __launch_bounds__(64) void ssm_scan_k(const float* proj, const float* a_re, const float* a_im, const float* log_dt, const float* b_re, const float* b_im, float* SRe, float* SIm) {
    const int b = blockIdx.x >> 5, g = blockIdx.x & 31, n = threadIdx.x;
    const float ar = a_re[g * 64 + n], ai = a_im[g * 64 + n], dt = expf(log_dt[g]);
    const float decay = expf(dt * ar), abr = decay * cosf(dt * ai), abi = decay * sinf(dt * ai);
    const float inv = 1.f / (ar * ar + ai * ai), nr = abr - 1.f, ni = abi;
    const float fr = (nr * ar + ni * ai) * inv, fi = (ni * ar - nr * ai) * inv;
    float bbr[16], bbi[16];
#pragma unroll
    for (int j = 0; j < 16; ++j) { const float br = b_re[(g * 64 + n) * 16 + j], bi = b_im[(g * 64 + n) * 16 + j]; bbr[j] = fr * br - fi * bi; bbi[j] = fr * bi + fi * br; }
    float sr = 0.f, si = 0.f;
    for (int t = 0; t < SEQ; ++t) {
        const long long row = (long long)b * SEQ + t;
        const float* u = proj + row * INW + OFF_SSM + g * 16;
        float bur = 0.f, bui = 0.f;
#pragma unroll
        for (int j = 0; j < 16; ++j) { const float uj = u[j]; bur = fmaf(bbr[j], uj, bur); bui = fmaf(bbi[j], uj, bui); }
        const float nsr = abr * sr - abi * si + bur, nsi = abr * si + abi * sr + bui;
        sr = nsr; si = nsi;
        SRe[(row * 32 + g) * 64 + n] = sr; SIm[(row * 32 + g) * 64 + n] = si;
    }
}
__global__ void ssm_y_k(const float* proj, const float* SRe, const float* SIm, const float* c_re, const float* c_im, const float* dsk, float* YG, int R) {
    const long long n = (long long)R * 512;
    for (long long idx = (long long)blockIdx.x * blockDim.x + threadIdx.x; idx < n; idx += (long long)gridDim.x * blockDim.x) {
        const long long row = idx >> 9; const int c = (int)(idx & 511), g = c >> 4;
        const float* sr = SRe + (row * 32 + g) * 64; const float* si = SIm + (row * 32 + g) * 64;
        const float* cr = c_re + c * 64; const float* ci = c_im + c * 64;
        float y = 0.f;
        for (int k = 0; k < 64; ++k) y += sr[k] * cr[k] - si[k] * ci[k];
        y += dsk[c] * proj[row * INW + OFF_SSM + c];
        YG[idx] = gelu_tanh(y);
    }
}
__global__ void glu_k(const float* GH, float* SSMH, int R) {
    const long long n = (long long)R * 512;
    for (long long idx = (long long)blockIdx.x * blockDim.x + threadIdx.x; idx < n; idx += (long long)gridDim.x * blockDim.x) {
        const long long row = idx >> 9; const int c = (int)(idx & 511);
        SSMH[idx] = GH[row * 1024 + c] * sigmoidf_(GH[row * 1024 + 512 + c]);
    }
}
__global__ void pool_k(const float* proj, float* POOLED, int R) {
    const long long n = (long long)R * 512;
    for (long long idx = (long long)blockIdx.x * blockDim.x + threadIdx.x; idx < n; idx += (long long)gridDim.x * blockDim.x) {
        const long long row = idx >> 9; const int c = (int)(idx & 511), gi = c >> 7, w = 2 << gi, t = (int)(row % SEQ);
        const int cnt = t + 1 < w ? t + 1 : w;
        float s = 0.f;
        for (int j = 0; j < cnt; ++j) s += proj[(row - j) * INW + OFF_POOL + c];
        POOLED[idx] = s / (float)cnt - proj[row * INW + OFF_POOL + c];
    }
}
__global__ void scale_cols_k(float* X, const float* sc, int R, int C) {
    const long long n = (long long)R * C;
    for (long long idx = (long long)blockIdx.x * blockDim.x + threadIdx.x; idx < n; idx += (long long)gridDim.x * blockDim.x) X[idx] *= sc[idx % C];
}
__global__ void merge_k(const float* BR, const float* proj, const float* b_gate, float* MERGED, int bidx, int R) {
    const long long n = (long long)R * 1024;
    for (long long idx = (long long)blockIdx.x * blockDim.x + threadIdx.x; idx < n; idx += (long long)gridDim.x * blockDim.x) {
        const long long row = idx >> 10; const int c = (int)(idx & 1023);
        const float gt = sigmoidf_(proj[row * INW + OFF_GATE + bidx * 1024 + c] + b_gate[bidx * 1024 + c]);
        const float v = gt * BR[idx];
        MERGED[idx] = bidx == 0 ? v : MERGED[idx] + v;
    }
}
__global__ void add_ln_k(const float* Xin, const float* T, const float* g, const float* b, float* Xout, int R) {
    const int lane = threadIdx.x & 63; const long long wid0 = ((long long)blockIdx.x * blockDim.x + threadIdx.x) >> 6, nw = ((long long)gridDim.x * blockDim.x) >> 6;
    for (long long row = wid0; row < R; row += nw) {
        float4 v[4]; float s = 0.f;
#pragma unroll
        for (int j = 0; j < 4; ++j) { const float4 x = *(const float4*)(Xin + row * 1024 + j * 256 + lane * 4), t = *(const float4*)(T + row * 1024 + j * 256 + lane * 4);
            v[j].x = DN_ALPHA * x.x + t.x; v[j].y = DN_ALPHA * x.y + t.y; v[j].z = DN_ALPHA * x.z + t.z; v[j].w = DN_ALPHA * x.w + t.w; s += (v[j].x + v[j].y) + (v[j].z + v[j].w); }
        const float mean = wsum(s) * (1.f / 1024.f); float q = 0.f;
#pragma unroll
        for (int j = 0; j < 4; ++j) { v[j].x -= mean; v[j].y -= mean; v[j].z -= mean; v[j].w -= mean; q += (v[j].x * v[j].x + v[j].y * v[j].y) + (v[j].z * v[j].z + v[j].w * v[j].w); }
        const float rstd = rsqrtf(wsum(q) * (1.f / 1024.f) + LN_EPS);
#pragma unroll
        for (int j = 0; j < 4; ++j) { const float4 gg = *(const float4*)(g + j * 256 + lane * 4), bb = *(const float4*)(b + j * 256 + lane * 4); float4 o;
            o.x = v[j].x * rstd * gg.x + bb.x; o.y = v[j].y * rstd * gg.y + bb.y; o.z = v[j].z * rstd * gg.z + bb.z; o.w = v[j].w * rstd * gg.w + bb.w;
            *(float4*)(Xout + row * 1024 + j * 256 + lane * 4) = o; }
    }
}
__global__ void softmax256_k(float* SC, int R) {
    const int lane = threadIdx.x & 63; const long long wid0 = ((long long)blockIdx.x * blockDim.x + threadIdx.x) >> 6, nw = ((long long)gridDim.x * blockDim.x) >> 6;
    for (long long w = wid0; w < (long long)R * 4; w += nw) {
        float4* p = (float4*)(SC + w * 256 + lane * 4); float4 v = *p;
        const float m = wmax(fmaxf(fmaxf(v.x, v.y), fmaxf(v.z, v.w)));
        v.x = expf(v.x - m); v.y = expf(v.y - m); v.z = expf(v.z - m); v.w = expf(v.w - m);
        const float inv = 1.f / wsum((v.x + v.y) + (v.z + v.w));
        v.x *= inv; v.y *= inv; v.z *= inv; v.w *= inv; *p = v;
    }
}
__global__ void router_k(const float* X, const float* wr, const float* br, int* cnt, int* list, float* wlist, int* tope, float* topw, int R, int cap) {
    const int lane = threadIdx.x & 63; const long long wid0 = ((long long)blockIdx.x * blockDim.x + threadIdx.x) >> 6, nw = ((long long)gridDim.x * blockDim.x) >> 6;
    for (long long row = wid0; row < R; row += nw) {
        float lg[8];
#pragma unroll
        for (int e = 0; e < 8; ++e) lg[e] = 0.f;
        for (int j = 0; j < 16; ++j) { const int k = j * 64 + lane; const float xv = X[row * 1024 + k];
#pragma unroll
            for (int e = 0; e < 8; ++e) lg[e] = fmaf(xv, wr[k * 8 + e], lg[e]); }
#pragma unroll
        for (int e = 0; e < 8; ++e) lg[e] = wsum(lg[e]) + br[e];
        int i1 = 0; float v1 = lg[0];
#pragma unroll
        for (int e = 1; e < 8; ++e) if (lg[e] > v1) { v1 = lg[e]; i1 = e; }
        int i2 = -1; float v2 = -3.0e38f;
#pragma unroll
        for (int e = 0; e < 8; ++e) if (e != i1 && lg[e] > v2) { v2 = lg[e]; i2 = e; }
        const float w2 = 1.f / (1.f + expf(v1 - v2)), w1 = 1.f - w2;
        if (lane == 0) {
            const int p1 = atomicAdd(&cnt[i1], 1); list[(long long)i1 * cap + p1] = (int)row; wlist[(long long)i1 * cap + p1] = w1;
            const int p2 = atomicAdd(&cnt[i2], 1); list[(long long)i2 * cap + p2] = (int)row; wlist[(long long)i2 * cap + p2] = w2;
            tope[row * 2] = i1; tope[row * 2 + 1] = i2; topw[row * 2] = w1; topw[row * 2 + 1] = w2;
        }
    }
}

struct Naive {
    hipStream_t st; void* const* in; int R, nb;
    float *XA, *XB, *PROJ, *SRE, *SIM, *YG, *GH, *SSMH, *POOLED, *MIXED, *ATTNO, *BR, *MERGED, *T, *Q, *KV, *SC, *XO, *H, *wlist, *topw;
    int *cnt, *list, *tope;
    const float* I(int i, size_t layer_stride, int layer) const { return (const float*)in[i] + layer_stride * layer; }

    static size_t bytes_needed(int R) {
        const size_t r = (size_t)R;
        return r * 1024 * 4 * 2 + r * INW * 4 + r * 2048 * 4 * 2 + r * 512 * 4 * 5 + (4u << 20);
    }
    void carve(unsigned char* base, int R_, int nb_) {
        R = R_; nb = nb_; const size_t r = (size_t)R; size_t o = 0;
        auto take = [&](size_t bytes) { unsigned char* p = base + o; o += (bytes + 255) & ~(size_t)255; return p; };
        XA = (float*)take(r * 1024 * 4); XB = (float*)take(r * 1024 * 4);
        unsigned char* projR = take(r * INW * 4); PROJ = (float*)projR;
        unsigned char* sstR = take(r * 2048 * 4 * 2); SRE = (float*)sstR; SIM = SRE + r * 2048;
        YG = (float*)take(r * 512 * 4); SSMH = (float*)take(r * 512 * 4); POOLED = (float*)take(r * 512 * 4); MIXED = (float*)take(r * 512 * 4); ATTNO = (float*)take(r * 512 * 4);
        cnt = (int*)take(256); list = (int*)take(8 * r * 4); wlist = (float*)take(8 * r * 4); tope = (int*)take(r * 8); topw = (float*)take(r * 8);
        GH = (float*)sstR; BR = GH + r * 1024; MERGED = BR + r * 1024; T = MERGED + r * 1024;
        Q = (float*)projR; SC = Q + r * 1024; XO = SC + r * 1024; KV = XO + r * 1024;
        H = (float*)projR;
    }
    void gemm(const float* A, int lda, const float* B, int ldb, float* C, int ldc, int M, int N, int K, float alpha = 1.f, bool transb = false,
              const float* B2 = nullptr, int nz = 1, int zdiv = 1, long long sA1 = 0, long long sA2 = 0, long long sB1 = 0, long long sB2 = 0, long long sC1 = 0, long long sC2 = 0,
              const int* rowidx = nullptr, const int* mptr = nullptr, const int* orow = nullptr, const float* oscale = nullptr, int accum = 0) {
        GemmP p; memset(&p, 0, sizeof(p));
        p.A = A; p.B = B; p.B2 = B2; p.C = C; p.rowidx = rowidx; p.mptr = mptr; p.orow = orow; p.oscale = oscale;
        p.sA1 = sA1; p.sA2 = sA2; p.sB1 = sB1; p.sB2 = sB2; p.sC1 = sC1; p.sC2 = sC2;
        p.M = M; p.N = N; p.K = K; p.lda = lda; p.ldb = ldb; p.ldc = ldc; p.zdiv = zdiv; p.accum = accum; p.alpha = alpha;
        dim3 grid(N / 128, (M + 127) / 128, nz);
        if (B2) hipLaunchKernelGGL((gemm_k<false, true>), grid, dim3(256), 0, st, p);
        else if (transb) hipLaunchKernelGGL((gemm_k<true, false>), grid, dim3(256), 0, st, p);
        else hipLaunchKernelGGL((gemm_k<false, false>), grid, dim3(256), 0, st, p);
    }
    void mixer_proj(int L, const float* X) {
        gemm(X, 1024, I(2, (size_t)1024 * INW, L), INW, PROJ, INW, R, INW, 1024);
        hipLaunchKernelGGL(rotary_k, dim3(1024), dim3(256), 0, st, PROJ, R);
    }
    void mixer_attn(int L) { hipLaunchKernelGGL(swa_k, dim3(2048), dim3(256), 0, st, (const float*)PROJ, I(4, 8, L), ATTNO, R); }
    void mixer_ssm(int L) {
        hipLaunchKernelGGL(ssm_scan_k, dim3(nb * 32), dim3(64), 0, st, (const float*)PROJ, I(5, 2048, L), I(6, 2048, L), I(7, 32, L), I(8, 32768, L), I(9, 32768, L), SRE, SIM);
        hipLaunchKernelGGL(ssm_y_k, dim3(2048), dim3(256), 0, st, (const float*)PROJ, (const float*)SRE, (const float*)SIM, I(10, 32768, L), I(11, 32768, L), I(12, 512, L), YG, R);
        gemm(YG, 512, I(13, (size_t)512 * 1024, L), 1024, GH, 1024, R, 1024, 512);
        hipLaunchKernelGGL(glu_k, dim3(2048), dim3(256), 0, st, (const float*)GH, SSMH, R);
    }
    void mixer_pool(int L) {
        hipLaunchKernelGGL(pool_k, dim3(2048), dim3(256), 0, st, (const float*)PROJ, POOLED, R);
        gemm(POOLED, 512, I(14, (size_t)4 * 128 * 128, L), 128, MIXED, 512, R, 128, 128, 1.f, false, nullptr, 4, 4, 0, 128, 0, 128 * 128, 0, 128);
        hipLaunchKernelGGL(scale_cols_k, dim3(2048), dim3(256), 0, st, MIXED, I(15, 512, L), R, 512);
    }
    void mixer_merge(int L) {
        const float* srcs[3] = {ATTNO, SSMH, MIXED};
        for (int b = 0; b < 3; ++b) {
            gemm(srcs[b], 512, I(16 + b, (size_t)512 * 1024, L), 1024, BR, 1024, R, 1024, 512);
            hipLaunchKernelGGL(merge_k, dim3(2048), dim3(256), 0, st, (const float*)BR, (const float*)PROJ, I(3, 3072, L), MERGED, b, R);
        }
    }
    void mixer_out(int L, const float* X, float* Xo) {
        gemm(MERGED, 1024, I(19, (size_t)1024 * 1024, L), 1024, T, 1024, R, 1024, 1024);
        hipLaunchKernelGGL(add_ln_k, dim3(2048), dim3(256), 0, st, X, (const float*)T, I(20, 1024, L), I(21, 1024, L), Xo, R);
    }
    void xattn_qkv(int L, const float* X) {
        gemm(X, 1024, I(22, (size_t)1024 * 1024, L), 1024, Q, 1024, R, 1024, 1024);
        gemm((const float*)in[1], 1024, I(23, (size_t)1024 * 2048, L), 2048, KV, 2048, nb * 256, 2048, 1024);
    }
    void xattn_core() {
        const long long sQ = (long long)SEQ * 1024, sKV = (long long)256 * 2048;
        gemm(Q, 1024, KV, 2048, SC, 1024, SEQ, 256, 256, 0.0625f, true, nullptr, nb * 4, 4, sQ, 256, sKV, 256, sQ, 256);
        hipLaunchKernelGGL(softmax256_k, dim3(2048), dim3(256), 0, st, SC, R);
        gemm(SC, 1024, KV + 1024, 2048, XO, 1024, SEQ, 256, 256, 1.f, false, nullptr, nb * 4, 4, sQ, 256, sKV, 256, sQ, 256);
    }
    void xattn_out(int L, const float* X, float* Xo) {
        gemm(XO, 1024, I(24, (size_t)1024 * 1024, L), 1024, T, 1024, R, 1024, 1024);
        hipLaunchKernelGGL(add_ln_k, dim3(2048), dim3(256), 0, st, X, (const float*)T, I(25, 1024, L), I(26, 1024, L), Xo, R);
    }
    void ffn_dense(int L, const float* X, float* Xo) {
        const int j = L / 2; const float* wgu = I(27, (size_t)1024 * 5632, j);
        gemm(X, 1024, wgu, 5632, H, 2816, R, 2816, 1024, 1.f, false, wgu + 2816);
        gemm(H, 2816, I(28, (size_t)2816 * 1024, j), 1024, T, 1024, R, 1024, 2816);
        hipLaunchKernelGGL(add_ln_k, dim3(2048), dim3(256), 0, st, X, (const float*)T, I(33, 1024, L), I(34, 1024, L), Xo, R);
    }
    void ffn_moe_route(int L, const float* X) {
        const int j = L / 2;
        hipMemsetAsync(cnt, 0, 256, st);
        hipLaunchKernelGGL(router_k, dim3(2048), dim3(256), 0, st, X, I(29, 1024 * 8, j), I(30, 8, j), cnt, list, wlist, tope, topw, R, R);
    }
    void ffn_moe(int L, const float* X, float* Xo) {
        const int j = L / 2;
        hipMemsetAsync(T, 0, (size_t)R * 1024 * 4, st);
        for (int e = 0; e < 8; ++e) {
            const float* wgu = I(31, (size_t)8 * 1024 * 7168, j) + (size_t)e * 1024 * 7168;
            const float* wdn = I(32, (size_t)8 * 3584 * 1024, j) + (size_t)e * 3584 * 1024;
            gemm(X, 1024, wgu, 7168, H, 3584, R, 3584, 1024, 1.f, false, wgu + 3584, 1, 1, 0, 0, 0, 0, 0, 0, list + (size_t)e * R, cnt + e);
            gemm(H, 3584, wdn, 1024, T, 1024, R, 1024, 3584, 1.f, false, nullptr, 1, 1, 0, 0, 0, 0, 0, 0, nullptr, cnt + e, list + (size_t)e * R, wlist + (size_t)e * R, 1);
        }
        hipLaunchKernelGGL(add_ln_k, dim3(2048), dim3(256), 0, st, X, (const float*)T, I(33, 1024, L), I(34, 1024, L), Xo, R);
    }
};
}
extern "C" void kernel_launch(void* const* d_in, const int* in_sizes, int n_in, void* d_out, int out_size, void* d_ws, size_t ws_size, hipStream_t stream) {
    (void)in_sizes; (void)n_in; (void)out_size; (void)ws_size;
    nv::Naive N; N.st = stream; N.in = d_in; N.carve((unsigned char*)d_ws, 32768, 8);
    const float* X = (const float*)d_in[0];
    float* bufs[2] = {N.XA, N.XB}; int cur = 0;
    for (int L = 0; L < 4; ++L) {
        N.mixer_proj(L, X); N.mixer_attn(L); N.mixer_ssm(L); N.mixer_pool(L); N.mixer_merge(L);
        float* X1 = bufs[cur]; cur ^= 1; N.mixer_out(L, X, X1);
        N.xattn_qkv(L, X1); N.xattn_core();
        float* X2 = bufs[cur]; cur ^= 1; N.xattn_out(L, X1, X2);
        float* X3 = (L == 3) ? (float*)d_out : bufs[cur]; cur ^= 1;
        if ((L & 1) == 0) N.ffn_dense(L, X2, X3);
        else { N.ffn_moe_route(L, X2); N.ffn_moe(L, X2, X3); }
        X = X3;
    }
}
```

```cpp
#define BUILD_MODE 1
#define DBG_BASE 0
#include <hip/hip_runtime.h>
#include <cstdio>
#include <cstdint>
#include <cstring>
#define LAS __attribute__((address_space(3)))
#define GAS __attribute__((address_space(1)))
#define DI __device__ __forceinline__
typedef unsigned short bf16_t;
typedef short bf16x8 __attribute__((ext_vector_type(8)));
typedef short s16x4 __attribute__((ext_vector_type(4)));
typedef float f32x4 __attribute__((ext_vector_type(4)));
typedef float f32x2 __attribute__((ext_vector_type(2)));
typedef float f32x16 __attribute__((ext_vector_type(16)));
typedef unsigned u32x4 __attribute__((ext_vector_type(4)));
typedef unsigned u32x2 __attribute__((ext_vector_type(2)));
typedef __bf16 bf16x2_t __attribute__((ext_vector_type(2)));
typedef GAS unsigned gu32;
#define RLX_AGENT __ATOMIC_RELAXED, __HIP_MEMORY_SCOPE_AGENT

DI unsigned pk2(float lo, float hi) { f32x2 v = {lo, hi}; bf16x2_t b = __builtin_convertvector(v, bf16x2_t); return __builtin_bit_cast(unsigned, b); }
DI float bf2f(unsigned short b) { return __uint_as_float(((unsigned)b) << 16); }
DI float bflo(unsigned w) { return __uint_as_float(w << 16); }
DI float bfhi(unsigned w) { return __uint_as_float(w & 0xffff0000u); }
DI int opaque_v(int x) { asm volatile("" : "+v"(x)); return x; }
DI int opaque_i(int x) { asm volatile("" : "+s"(x)); return x; }
template <class T> DI T* opaque_s(T* p) { asm volatile("" : "+s"(p)); return p; }
DI float wave_sum(float v) {
#pragma unroll
    for (int o = 1; o < 64; o <<= 1) v += __shfl_xor(v, o);
    return v;
}
DI float fast_exp2(float x) { return __builtin_amdgcn_exp2f(x); }
DI float fast_rcp(float x) { return __builtin_amdgcn_rcpf(x); }
DI float sigmoid_f(float x) { return fast_rcp(1.f + fast_exp2(-1.4426950408889634f * x)); }
DI float silu_f(float x) { return x * sigmoid_f(x); }
DI float gelu_tanh_f(float x) { const float u = 0.7978845608028654f * (x + 0.044715f * x * x * x); return x * sigmoid_f(2.f * u); }

#define XB_TMO      128
#define XB_XCNT(j)  (256  + 64 * (j))
#define XB_XSUB(j)  (1280 + 64 * (j))
#define XB_XGEN(j)  (2304 + 64 * (j))
#define XB_TOP      3328
#define XB_TOPGEN   3392
#define XCD_BAR_WORDS 3456
#define XB_SPIN_CAP (1u << 22)
DI unsigned xb_ld(unsigned* p)              { return __hip_atomic_load(p, __ATOMIC_RELAXED, __HIP_MEMORY_SCOPE_AGENT); }
DI unsigned xb_add(unsigned* p, unsigned v) { return __hip_atomic_fetch_add(p, v, __ATOMIC_RELAXED, __HIP_MEMORY_SCOPE_AGENT); }
DI unsigned xb_xcc_id() { return (unsigned)__builtin_amdgcn_s_getreg((3 << 11) | 20) & 0xFu; }
#define XB_SPIN(cond, bar) do { unsigned _sp = 0; while (cond) { __builtin_amdgcn_s_sleep(1); \
    if ((++_sp & 255u) == 0u) { if (xb_ld(&(bar)[XB_TMO])) break; if (_sp > XB_SPIN_CAP) { atomicAdd(&(bar)[XB_TMO], 1u); break; } } } } while (0)
struct XcdBarrier { unsigned* bar; unsigned x; volatile LAS unsigned* st; };
DI XcdBarrier xcd_barrier_post(unsigned* bar, volatile LAS unsigned* st) {
    XcdBarrier b; b.bar = bar; b.x = xb_xcc_id(); b.st = st;
    if (threadIdx.x == 0) (void)xb_add(&bar[XB_XCNT(b.x)], 1u);
    return b;
}
DI void xcd_barrier_complete(unsigned* bar, unsigned x, unsigned& nloc, unsigned& nx) {
    const unsigned G = gridDim.x * gridDim.y * gridDim.z;
    unsigned sum, cnt, mine, sp = 0u;
    for (;;) {
        sum = 0u; cnt = 0u; mine = 0u;
#pragma unroll
        for (unsigned j = 0; j < 16; ++j) { const unsigned c = xb_ld(&bar[XB_XCNT(j)]); sum += c; cnt += (c > 0u) ? 1u : 0u; mine = (j == x) ? c : mine; }
        if (sum == G) break;
        __builtin_amdgcn_s_sleep(1);
        if ((++sp & 255u) == 0u) { if (xb_ld(&bar[XB_TMO])) break; if (sp > XB_SPIN_CAP) { atomicAdd(&bar[XB_TMO], 1u); break; } }
    }
    nloc = mine > 0u ? mine : 1u; nx = cnt > 0u ? cnt : 1u;
}
DI void xcd_barrier(const XcdBarrier& b) {
    asm volatile("s_waitcnt vmcnt(0)" ::: "memory");
    __syncthreads();
    if (threadIdx.x == 0) {
        unsigned* bar = b.bar;
        __builtin_amdgcn_s_waitcnt(0);
        unsigned nloc = b.st[0], nx = b.st[1];
        if (nloc == 0u) { xcd_barrier_complete(bar, b.x, nloc, nx); b.st[0] = nloc; b.st[1] = nx; }
        const unsigned old = xb_add(&bar[XB_XSUB(b.x)], 1u);
        const unsigned gen = old / nloc;
        if (old + 1u == (gen + 1u) * nloc) {
            __builtin_amdgcn_fence(__ATOMIC_RELEASE, "agent");
            asm volatile("s_waitcnt vmcnt(0)" ::: "memory");
            const unsigned og = xb_add(&bar[XB_TOP], 1u);
            const unsigned tg = og / nx;
            if (og + 1u == (tg + 1u) * nx) xb_add(&bar[XB_TOPGEN], 1u);
            else XB_SPIN(xb_ld(&bar[XB_TOPGEN]) == tg, bar);
            __builtin_amdgcn_fence(__ATOMIC_ACQUIRE, "agent");
            xb_add(&bar[XB_XGEN(b.x)], 1u);
            asm volatile("s_waitcnt vmcnt(0)" ::: "memory");
        } else {
            XB_SPIN(xb_ld(&bar[XB_XGEN(b.x)]) == gen, bar);
            __builtin_amdgcn_fence(__ATOMIC_ACQUIRE, "agent");
            asm volatile("s_waitcnt vmcnt(0)" ::: "memory");
        }
    }
    __syncthreads();
}

namespace pg {
constexpr int BM = 256, BK = 64, HALF = 128, HTB = HALF * BK * 2, STAGE_BYTES = 8 * HTB, NXCD = 8, WGM = 8;
__host__ __device__ __forceinline__ int lds_byte(int r, int c) { const int st = (r >> 4) * 2 + (c >> 5), rr = r & 15, cc = c & 31, ob = rr * 64 + cc * 2; return st * 1024 + (ob ^ (((ob >> 9) & 1) << 5)); }
__host__ __device__ __forceinline__ void stage_rc(int b, int& R, int& C) { const int st = b / 1024, sb = b % 1024, swz = sb ^ (((sb >> 9) & 1) << 5); R = (st >> 1) * 16 + swz / 64; C = (st & 1) * 32 + (swz % 64) / 2; }
__host__ __device__ __forceinline__ int perm32(int rho) { const int n = rho >> 4, i = rho & 15; return 8 * (i >> 2) + 4 * n + (i & 3); }

struct Unit { int pm, pn, z, row0, col0; const char* a; const char* b; };
struct Shape { int K, lda, ldb; };

DI bool tile_of(int i, int G, int c, int nM, int nN, int& pm, int& pn) {
    const int nwg = nM * nN; const long L = (long)i * G + c; if (L >= nwg) return false;
    int wgid = (int)L; { const int q = nwg / NXCD, r = nwg % NXCD, xcd = wgid % NXCD, off = wgid / NXCD; wgid = (xcd < r ? xcd * (q + 1) : r * (q + 1) + (xcd - r) * q) + off; }
    const int nig = WGM * nN, gid = wgid / nig, fm = gid * WGM, gsz = (nM - fm) < WGM ? (nM - fm) : WGM;
    pm = fm + ((wgid % nig) % gsz); pn = (wgid % nig) / gsz; return true;
}
struct PlainOrder {
    const char* A; const char* Bt; int nM, nN, G, c; size_t astep, bstep;
    DI void init(const void* A_, const void* Bt_, int M, int N, int lda, int ldb, int G_, int c_) { A = (const char*)A_; Bt = (const char*)Bt_; nM = M / BM; nN = N / BM; G = G_; c = c_; astep = (size_t)BM * lda * 2; bstep = (size_t)BM * ldb * 2; }
    DI bool next(int i, Unit& u) const { if (!tile_of(i, G, c, nM, nN, u.pm, u.pn)) return false; u.z = 0; u.row0 = u.pm * BM; u.col0 = u.pn * BM; u.a = A + (size_t)u.pm * astep; u.b = Bt + (size_t)u.pn * bstep; return true; }
};

template <class Epi, class Sched, bool ALIGN_EPI>
DI void gemm_phase(LAS unsigned char* lds, const Shape g, const Sched& S, const Epi& E) {
    const int tid = opaque_v((int)threadIdx.x), wid = __builtin_amdgcn_readfirstlane(tid >> 6), lane = tid & 63, wr = wid >> 2, wc = wid & 3, fr = lane & 15, fq = lane >> 4;
    const int nt = g.K / BK;
    unsigned voffA[2], voffB[2];
#pragma unroll
    for (int i = 0; i < 2; ++i) { int R, C; stage_rc(tid * 16 + i * 8192, R, C); const int Rb = Epi::PERM ? ((R & ~31) + perm32(R & 31)) : R;
        voffA[i] = (unsigned)(R * g.lda + C) * 2u; voffB[i] = (unsigned)(Rb * g.ldb + C) * 2u; }
    const size_t kstep = (size_t)(BK * 2);
    const size_t hstepA = (size_t)HALF * g.lda * 2, hstepB = (size_t)HALF * g.ldb * 2;
    const unsigned ldsw = (unsigned)wid * 1024u;
    const int aoff = lds_byte(wr * 64 + fr, fq * 8), boff = lds_byte(wc * 32 + fr, fq * 8);
#define PG8_SA(b, h) (((b) * 2 + (h)) * HTB)
#define PG8_SB(b, h) ((4 + (b) * 2 + (h)) * HTB)
#define PG8_STAGE(bufoff, gbase, voff) do { _Pragma("unroll") for (int _i = 0; _i < 2; ++_i) { unsigned _vo = (voff)[_i]; asm volatile("" : "+v"(_vo)); \
        __builtin_amdgcn_global_load_lds((const unsigned*)((const char*)(gbase) + _vo), (LAS unsigned*)(lds + (bufoff) + ldsw + _i * 8192), 16, 0, 0); } } while (0)
#define PG8_LDA(dst, b, h) do { _Pragma("unroll") for (int m = 0; m < 4; ++m) _Pragma("unroll") for (int k = 0; k < 2; ++k) dst[m][k] = *(const LAS bf16x8*)(lds + PG8_SA(b, h) + aoff + m * 2048 + k * 1024); } while (0)
#define PG8_LDB(dst, b, h) do { _Pragma("unroll") for (int n = 0; n < 2; ++n) _Pragma("unroll") for (int k = 0; k < 2; ++k) dst[n][k] = *(const LAS bf16x8*)(lds + PG8_SB(b, h) + boff + n * 2048 + k * 1024); } while (0)
#define PG8_MMA(ai, bj, At, Bt) do { __builtin_amdgcn_s_setprio(1); _Pragma("unroll") for (int m = 0; m < 4; ++m) _Pragma("unroll") for (int n = 0; n < 2; ++n) _Pragma("unroll") for (int k = 0; k < 2; ++k) \
        acc[ai][bj][m][n] = __builtin_amdgcn_mfma_f32_16x16x32_bf16(Bt[n][k], At[m][k], acc[ai][bj][m][n], 0, 0, 0); __builtin_amdgcn_s_setprio(0); } while (0)
#define PG8_WAIT_V(n) asm volatile("s_waitcnt vmcnt(" #n ")" ::: "memory")
#define PG8_WAIT_L(n) asm volatile("s_waitcnt lgkmcnt(" #n ")" ::: "memory")
#define PG8_BAR __builtin_amdgcn_s_barrier()
#define PG8_SCHED __builtin_amdgcn_sched_barrier(0)
    Unit cur, nxt; int ui = 0;
    if (!S.next(0, cur)) return;
    f32x4 acc[2][2][4][2];
#pragma unroll
    for (int a = 0; a < 2; ++a)
#pragma unroll
        for (int b = 0; b < 2; ++b)
#pragma unroll
            for (int m = 0; m < 4; ++m)
#pragma unroll
                for (int n = 0; n < 2; ++n) acc[a][b][m][n] = (f32x4){0.f, 0.f, 0.f, 0.f};
    bf16x8 At[4][2], B0[2][2], B1[2][2];
    const char* cA = cur.a; const char* cB = cur.b;
    PG8_STAGE(PG8_SB(0, 0), cB, voffB); PG8_STAGE(PG8_SB(0, 1), cB + hstepB, voffB); PG8_STAGE(PG8_SA(0, 0), cA, voffA); PG8_STAGE(PG8_SA(0, 1), cA + hstepA, voffA);
    if (wr == 1) PG8_BAR;
    PG8_WAIT_V(2); PG8_BAR;
    PG8_STAGE(PG8_SB(1, 0), cB + kstep, voffB); PG8_STAGE(PG8_SA(1, 0), cA + kstep, voffA); PG8_STAGE(PG8_SB(1, 1), cB + hstepB + kstep, voffB);
    PG8_WAIT_V(6); PG8_BAR;
    for (;;) {
        const bool has_next = S.next(ui + 1, nxt);
        const char* nA = has_next ? nxt.a : cA; const char* nB = has_next ? nxt.b : cB;
        for (int t = 0; t < nt; t += 2) {
            const bool last = (t == nt - 2);
            const char* a1 = cA + (size_t)(t + 1) * kstep;
            const char* a2 = last ? nA : cA + (size_t)(t + 2) * kstep; const char* b2 = last ? nB : cB + (size_t)(t + 2) * kstep;
            const char* a3 = a2 + kstep; const char* b3 = b2 + kstep;
            PG8_LDB(B0, 0, 0); PG8_LDB(B1, 0, 1); PG8_SCHED; PG8_LDA(At, 0, 0); PG8_STAGE(PG8_SA(1, 1), a1 + hstepA, voffA);
            PG8_WAIT_V(8); PG8_WAIT_L(0); PG8_BAR; PG8_MMA(0, 0, At, B0); PG8_MMA(0, 1, At, B1); PG8_BAR; PG8_SCHED;
            PG8_LDA(At, 0, 1); PG8_STAGE(PG8_SB(0, 0), b2, voffB); PG8_STAGE(PG8_SB(0, 1), b2 + hstepB, voffB); PG8_STAGE(PG8_SA(0, 0), a2, voffA);
            PG8_WAIT_V(8); PG8_WAIT_L(0); PG8_BAR; PG8_MMA(1, 0, At, B0); PG8_MMA(1, 1, At, B1); PG8_BAR; PG8_SCHED;
            PG8_LDB(B0, 1, 0); PG8_LDB(B1, 1, 1); PG8_SCHED; PG8_LDA(At, 1, 0); PG8_STAGE(PG8_SA(0, 1), a2 + hstepA, voffA);
            PG8_WAIT_V(8); PG8_WAIT_L(0); PG8_BAR; PG8_MMA(0, 0, At, B0); PG8_MMA(0, 1, At, B1); PG8_BAR; PG8_SCHED;
            PG8_LDA(At, 1, 1); PG8_STAGE(PG8_SB(1, 0), b3, voffB); PG8_STAGE(PG8_SB(1, 1), b3 + hstepB, voffB); PG8_STAGE(PG8_SA(1, 0), a3, voffA);
            PG8_WAIT_V(8); PG8_WAIT_L(0); PG8_BAR; PG8_MMA(1, 0, At, B0); PG8_MMA(1, 1, At, B1); PG8_BAR; PG8_SCHED;
        }
        if constexpr (ALIGN_EPI) { if (wr == 0) PG8_BAR; }
        if constexpr (!Epi::AFTER_DRAIN) { E(acc, cur, wr, wc, fr, fq); }
        if (!has_next) break;
#pragma unroll
        for (int a = 0; a < 2; ++a)
#pragma unroll
            for (int b = 0; b < 2; ++b)
#pragma unroll
                for (int m = 0; m < 4; ++m)
#pragma unroll
                    for (int n = 0; n < 2; ++n) acc[a][b][m][n] = (f32x4){0.f, 0.f, 0.f, 0.f};
        cur = nxt; cA = nA; cB = nB; ++ui;
        if constexpr (ALIGN_EPI) { if (wr == 1) PG8_BAR; }
    }
    PG8_WAIT_V(0);
    if constexpr (!ALIGN_EPI) { if (wr == 0) PG8_BAR; }
    PG8_BAR;
    if constexpr (Epi::AFTER_DRAIN) { E.fused(acc, cur, wr, wc, fr, fq, lds, wid, lane); }
#undef PG8_SA
#undef PG8_SB
#undef PG8_STAGE
#undef PG8_LDA
#undef PG8_LDB
#undef PG8_MMA
#undef PG8_WAIT_V
#undef PG8_WAIT_L
#undef PG8_BAR
#undef PG8_SCHED
}
}
namespace fp {
constexpr int NTOK = 32768, SEQ = 4096, DM = 1024, INW = 4864, NL = 4, DFF = 2816, DFFE = 3584, NE = 8;
constexpr float ALPHA = 1.681792830507429f, LN_EPS = 1e-5f, LOG2E = 1.4426950408889634f;
constexpr float QSCALE = 0.125f * LOG2E, XQSCALE = 0.0625f * LOG2E;
constexpr int UG_STRIDE = 1024 * 640;
constexpr int MOE_ROWS = 65536 + 8 * 256;

constexpr size_t MiB = 1u << 20;
constexpr size_t al(size_t x) { return (x + 255) & ~(size_t)255; }
constexpr size_t WS_CTL = 0, CTL_BYTES = 1 * MiB;
constexpr int CW_BAR = 1024;
constexpr int CW_MOECNT = 8192;
constexpr int CW_ERR = 16384;
constexpr size_t WS_WIN = CTL_BYTES;                                       constexpr size_t SZ_WIN = (size_t)INW * DM * 2;
constexpr size_t WS_WGLU = WS_WIN + NL * SZ_WIN;                            constexpr size_t SZ_WGLU = (size_t)1024 * 512 * 2;
constexpr size_t WS_WPOOL = WS_WGLU + NL * SZ_WGLU;                         constexpr size_t SZ_WPOOL = (size_t)512 * 512 * 2;
constexpr size_t WS_WBR = WS_WPOOL + NL * SZ_WPOOL;                         constexpr size_t SZ_WBR = (size_t)1024 * 512 * 2;
constexpr size_t WS_WO = WS_WBR + NL * 3 * SZ_WBR;                          constexpr size_t SZ_WSQ = (size_t)1024 * 1024 * 2;
constexpr size_t WS_WQ = WS_WO + NL * SZ_WSQ;
constexpr size_t WS_WKV = WS_WQ + NL * SZ_WSQ;                              constexpr size_t SZ_WKV = (size_t)2048 * 1024 * 2;
constexpr size_t WS_WXO = WS_WKV + NL * SZ_WKV;
constexpr size_t WS_WGU = WS_WXO + NL * SZ_WSQ;                             constexpr size_t SZ_WGU = (size_t)2 * DFF * DM * 2;
constexpr size_t WS_WDN = WS_WGU + 2 * SZ_WGU;                              constexpr size_t SZ_WDN = (size_t)DM * DFF * 2;
constexpr size_t WS_MGU = WS_WDN + 2 * SZ_WDN;                              constexpr size_t SZ_MGU = (size_t)2 * DFFE * DM * 2;
constexpr size_t WS_MDN = WS_MGU + 2 * NE * SZ_MGU;                         constexpr size_t SZ_MDN = (size_t)DM * DFFE * 2;
constexpr size_t WS_ROPE = WS_MDN + 2 * NE * SZ_MDN;                        constexpr size_t SZ_ROPE = (size_t)SEQ * 16 * 4;
constexpr size_t WS_PWR = WS_ROPE + SZ_ROPE;                                constexpr size_t SZ_PWR = (size_t)32 * 33 * 64 * 8;
constexpr size_t WS_BBAR = WS_PWR + NL * SZ_PWR;                            constexpr size_t SZ_BBAR = (size_t)32 * 64 * 16 * 8;
constexpr size_t WS_KG = WS_BBAR + NL * SZ_BBAR;                            constexpr size_t SZ_KG = (size_t)32 * 32 * 256 * 4;
constexpr size_t WS_MT = WS_KG + NL * SZ_KG;                                constexpr size_t SZ_MT = (size_t)32 * 512 * 640 * 2;
constexpr size_t WS_PT = WS_MT + NL * SZ_MT;                                constexpr size_t SZ_PT = (size_t)32 * 256 * 512 * 2;
constexpr size_t WS_MEMB = WS_PT + NL * SZ_PT;                              constexpr size_t SZ_MEMB = (size_t)2048 * 1024 * 2;
constexpr size_t WS_KM = WS_MEMB + SZ_MEMB;                                 constexpr size_t SZ_KM = (size_t)2048 * 1024 * 2;
constexpr size_t WS_VT = WS_KM + NL * SZ_KM;                                constexpr size_t SZ_VT = (size_t)8 * 1024 * 256 * 2;
constexpr size_t WS_RTE = WS_VT + NL * SZ_VT;
constexpr size_t WS_RTP = WS_RTE + (size_t)NTOK * 8;
constexpr size_t WS_RTW = WS_RTP + (size_t)NTOK * 8;
constexpr size_t WS_SRC = WS_RTW + (size_t)NTOK * 8;
constexpr size_t WS_WSLOT = WS_SRC + (size_t)NE * NTOK * 4;
constexpr size_t WS_XF = al(WS_WSLOT + (size_t)MOE_ROWS * 4);              constexpr size_t SZ_XF = (size_t)NTOK * DM * 4;
constexpr size_t WS_XB = WS_XF + SZ_XF;                                     constexpr size_t SZ_XB = (size_t)NTOK * DM * 2;
constexpr size_t WS_T = WS_XB + SZ_XB;
constexpr size_t WS_SCR = WS_T + SZ_XF;
constexpr size_t WS_Q = WS_SCR;
constexpr size_t WS_KK = WS_Q + (size_t)NTOK * 512 * 2;
constexpr size_t WS_VV = WS_KK + (size_t)NTOK * 128 * 2;
constexpr size_t WS_U = WS_VV + (size_t)NTOK * 128 * 2;
constexpr size_t WS_UP = WS_U + (size_t)32 * UG_STRIDE * 2;
constexpr size_t WS_GT = WS_UP + (size_t)NTOK * 512 * 2;
constexpr size_t WS_ATTNO = WS_GT + (size_t)NTOK * 3072 * 2;
constexpr size_t WS_YG = WS_ATTNO + (size_t)NTOK * 512 * 2;
constexpr size_t WS_SSMH = WS_YG + (size_t)NTOK * 512 * 2;
constexpr size_t WS_POOLED = WS_SSMH + (size_t)NTOK * 512 * 2;
constexpr size_t WS_MIXED = WS_POOLED + (size_t)NTOK * 512 * 2;
constexpr size_t WS_MERGED = WS_MIXED + (size_t)NTOK * 512 * 2;
constexpr size_t WS_MIX_END = WS_MERGED + (size_t)NTOK * 1024 * 2;
constexpr size_t WS_XQ = WS_SCR;
constexpr size_t WS_PB = WS_XQ + SZ_XB;
constexpr size_t WS_XO = WS_PB + SZ_XB;
constexpr size_t WS_RS = WS_XO + SZ_XB;
constexpr size_t WS_H = WS_SCR;
constexpr size_t WS_XG = WS_H + (size_t)MOE_ROWS * DFFE * 2;
constexpr size_t WS_FFN_END = WS_XG + (size_t)MOE_ROWS * DM * 2;
constexpr size_t WS_FAST_END = al(WS_FFN_END > WS_MIX_END ? WS_FFN_END : WS_MIX_END);

constexpr int LDS_BYTES = 147456, LDS_CTL = 147456 - 512;

DI u32x4 pack8(const f32x4& a, const f32x4& b) { u32x4 w; w.x = pk2(a[0], a[1]); w.y = pk2(a[2], a[3]); w.z = pk2(b[0], b[1]); w.w = pk2(b[2], b[3]); return w; }
#define EPI_ROWS(ai, m) _Pragma("unroll") for (int ai = 0; ai < 2; ++ai) _Pragma("unroll") for (int m = 0; m < 4; ++m)
DI void st16(void* ub, unsigned off, const u32x4& v) { *(u32x4*)((char*)ub + off) = v; }
DI void st16f(void* ub, unsigned off, const f32x4& v) { *(f32x4*)((char*)ub + off) = v; }
DI u32x4 ld16(const void* ub, unsigned off) { return *(const u32x4*)((const char*)ub + off); }
DI f32x4 ld16f(const void* ub, unsigned off) { return *(const f32x4*)((const char*)ub + off); }
DI void mul8(f32x4& v0, f32x4& v1, const u32x4& g) { v0[0] *= bflo(g.x); v0[1] *= bfhi(g.x); v0[2] *= bflo(g.y); v0[3] *= bfhi(g.y); v1[0] *= bflo(g.z); v1[1] *= bfhi(g.z); v1[2] *= bflo(g.w); v1[3] *= bfhi(g.w); }
DI void add8(f32x4& v0, f32x4& v1, const u32x4& g) { v0[0] += bflo(g.x); v0[1] += bfhi(g.x); v0[2] += bflo(g.y); v0[3] += bfhi(g.y); v1[0] += bflo(g.z); v1[1] += bfhi(g.z); v1[2] += bflo(g.w); v1[3] += bfhi(g.w); }

struct EpiInProj {
    static constexpr bool PERM = true, AFTER_DRAIN = false;
    bf16_t *Q, *KK, *VV, *U, *UP, *GT; const float* bgate; const float* rope;
    DI void operator()(const f32x4 (&acc)[2][2][4][2], const pg::Unit& u, int wr, int wc, int fr, int fq) const {
        const int pn = u.pn, r0 = u.pm * 256 + wr * 64;
        if (pn <= 2) {
            const bool rot = (wc & 1) == 0 && fq < 2; const float sg = fq == 0 ? -1.f : 1.f;
            EPI_ROWS(ai, m) { const int ru = r0 + ai * 128 + m * 16;
                f32x4 c0 = {0.f, 0.f, 0.f, 0.f}, c1 = c0, s0 = c0, s1 = c0;
                if (rot) { const float* cs = rope + (size_t)((ru & (SEQ - 1)) * 16); const unsigned lo = (unsigned)fr * 64u; c0 = ld16f(cs, lo); c1 = ld16f(cs, lo + 16); s0 = ld16f(cs, lo + 32); s1 = ld16f(cs, lo + 48); }
#pragma unroll
                for (int bj = 0; bj < 2; ++bj) { f32x4 v0 = acc[ai][bj][m][0], v1 = acc[ai][bj][m][1];
                    if (pn < 2 || bj == 0) {
                        f32x4 p0, p1;
#pragma unroll
                        for (int j = 0; j < 4; ++j) { p0[j] = __shfl_xor(v0[j], 16); p1[j] = __shfl_xor(v1[j], 16); }
                        if (rot) { v0 = v0 * c0 + sg * (p0 * s0); v1 = v1 * c1 + sg * (p1 * s1); }
                        if (pn < 2) st16(Q + (size_t)ru * 512 + pn * 256 + bj * 128 + wc * 32, (unsigned)(fr * 512 + fq * 8) * 2u, pack8(v0 * QSCALE, v1 * QSCALE));
                        else st16(KK + (size_t)ru * 128 + wc * 32, (unsigned)(fr * 128 + fq * 8) * 2u, pack8(v0, v1));
                    } else st16(VV + (size_t)ru * 128 + wc * 32, (unsigned)(fr * 128 + fq * 8) * 2u, pack8(v0, v1));
                } }
        } else if (pn < 5) {
            EPI_ROWS(ai, m) { const int ru = r0 + ai * 128 + m * 16;
#pragma unroll
                for (int bj = 0; bj < 2; ++bj) { const int cu = (pn - 3) * 256 + bj * 128 + wc * 32;
                    st16(U + (size_t)(cu >> 4) * UG_STRIDE + (size_t)(ru >> 5) * 640 + (ru & 31) * 16, (unsigned)((fq >> 1) * UG_STRIDE + fr * 16 + (fq & 1) * 8) * 2u, pack8(acc[ai][bj][m][0], acc[ai][bj][m][1])); } }
        } else if (pn < 7) {
            EPI_ROWS(ai, m) { const int ru = r0 + ai * 128 + m * 16;
#pragma unroll
                for (int bj = 0; bj < 2; ++bj) st16(UP + (size_t)ru * 512 + (pn - 5) * 256 + bj * 128 + wc * 32, (unsigned)(fr * 512 + fq * 8) * 2u, pack8(acc[ai][bj][m][0], acc[ai][bj][m][1])); }
        } else {
            f32x4 b0[2], b1[2];
#pragma unroll
            for (int bj = 0; bj < 2; ++bj) { const float* bp = bgate + (pn - 7) * 256 + bj * 128 + wc * 32; b0[bj] = ld16f(bp, (unsigned)fq * 32u); b1[bj] = ld16f(bp, (unsigned)fq * 32u + 16u); }
            EPI_ROWS(ai, m) { const int ru = r0 + ai * 128 + m * 16;
#pragma unroll
                for (int bj = 0; bj < 2; ++bj) { f32x4 v0 = acc[ai][bj][m][0] + b0[bj], v1 = acc[ai][bj][m][1] + b1[bj];
#pragma unroll
                    for (int j = 0; j < 4; ++j) { v0[j] = sigmoid_f(v0[j]); v1[j] = sigmoid_f(v1[j]); }
                    st16(GT + (size_t)ru * 3072 + (pn - 7) * 256 + bj * 128 + wc * 32, (unsigned)(fr * 3072 + fq * 8) * 2u, pack8(v0, v1)); } }
        }
    }
};
struct EpiBf16 {
    static constexpr bool PERM = true, AFTER_DRAIN = false;
    bf16_t* O; int ldc; float scale;
    DI void operator()(const f32x4 (&acc)[2][2][4][2], const pg::Unit& u, int wr, int wc, int fr, int fq) const {
        const unsigned lo = (unsigned)(fr * ldc + fq * 8) * 2u;
        EPI_ROWS(ai, m) { bf16_t* ub = O + (size_t)(u.row0 + ai * 128 + wr * 64 + m * 16) * ldc + u.col0 + wc * 32;
#pragma unroll
            for (int bj = 0; bj < 2; ++bj) st16(ub + bj * 128, lo, pack8(acc[ai][bj][m][0] * scale, acc[ai][bj][m][1] * scale)); }
    }
};
template <int ACT> struct EpiGlu {
    static constexpr bool PERM = true, AFTER_DRAIN = false;
    bf16_t* O; int ldc;
    DI void operator()(const f32x4 (&acc)[2][2][4][2], const pg::Unit& u, int wr, int wc, int fr, int fq) const {
        const unsigned lo = (unsigned)(fr * ldc + fq * 8) * 2u;
        EPI_ROWS(ai, m) { bf16_t* ub = O + (size_t)(u.row0 + ai * 128 + wr * 64 + m * 16) * ldc + u.pn * 128 + wc * 32;
            f32x4 o0, o1;
#pragma unroll
            for (int j = 0; j < 4; ++j) {
                if (ACT == 0) { o0[j] = acc[ai][0][m][0][j] * sigmoid_f(acc[ai][1][m][0][j]); o1[j] = acc[ai][0][m][1][j] * sigmoid_f(acc[ai][1][m][1][j]); }
                else { o0[j] = silu_f(acc[ai][0][m][0][j]) * acc[ai][1][m][0][j]; o1[j] = silu_f(acc[ai][0][m][1][j]) * acc[ai][1][m][1][j]; } }
            st16(ub, lo, pack8(o0, o1)); }
    }
};
struct EpiColScale {
    static constexpr bool PERM = true, AFTER_DRAIN = false;
    bf16_t* O; int ldc; const float* sc;
    DI void operator()(const f32x4 (&acc)[2][2][4][2], const pg::Unit& u, int wr, int wc, int fr, int fq) const {
        f32x4 s0[2], s1[2]; const unsigned lo = (unsigned)(fr * ldc + fq * 8) * 2u;
#pragma unroll
        for (int bj = 0; bj < 2; ++bj) { const float* sp = sc + u.col0 + bj * 128 + wc * 32; s0[bj] = ld16f(sp, (unsigned)fq * 32u); s1[bj] = ld16f(sp, (unsigned)fq * 32u + 16u); }
        EPI_ROWS(ai, m) { bf16_t* ub = O + (size_t)(u.row0 + ai * 128 + wr * 64 + m * 16) * ldc + u.col0 + wc * 32;
#pragma unroll
            for (int bj = 0; bj < 2; ++bj) st16(ub + bj * 128, lo, pack8(acc[ai][bj][m][0] * s0[bj], acc[ai][bj][m][1] * s1[bj])); }
    }
};
template <bool ACCUM> struct EpiBranch {
    static constexpr bool PERM = true, AFTER_DRAIN = false;
    const bf16_t* GT; bf16_t* MG; int bidx;
    DI void operator()(const f32x4 (&acc)[2][2][4][2], const pg::Unit& u, int wr, int wc, int fr, int fq) const {
        const unsigned lg = (unsigned)(fr * 3072 + fq * 8) * 2u, lm = (unsigned)(fr * 1024 + fq * 8) * 2u;
        EPI_ROWS(ai, m) { const size_t ru = (size_t)(u.row0 + ai * 128 + wr * 64 + m * 16); const int cu = u.col0 + wc * 32;
#pragma unroll
            for (int bj = 0; bj < 2; ++bj) { f32x4 v0 = acc[ai][bj][m][0], v1 = acc[ai][bj][m][1];
                mul8(v0, v1, ld16(GT + ru * 3072 + bidx * 1024 + cu + bj * 128, lg));
                bf16_t* mp = MG + ru * 1024 + cu + bj * 128;
                if (ACCUM) add8(v0, v1, ld16(mp, lm));
                st16(mp, lm, pack8(v0, v1)); } }
    }
};
struct EpiResid {
    static constexpr bool PERM = false, AFTER_DRAIN = false;
    const float* X; float* T;
    DI void operator()(const f32x4 (&acc)[2][2][4][2], const pg::Unit& u, int wr, int wc, int fr, int fq) const {
        const unsigned lo = (unsigned)(fr * 1024 + fq * 4) * 4u;
        EPI_ROWS(ai, m) { const size_t off = (size_t)(u.row0 + ai * 128 + wr * 64 + m * 16) * 1024 + u.col0 + wc * 32;
#pragma unroll
            for (int bj = 0; bj < 2; ++bj)
#pragma unroll
                for (int n = 0; n < 2; ++n) st16f(T + off + bj * 128 + n * 16, lo, ALPHA * ld16f(X + off + bj * 128 + n * 16, lo) + acc[ai][bj][m][n]); }
    }
};
struct EpiSsmE {
    static constexpr bool PERM = false, AFTER_DRAIN = true;
    bf16_t* U; const float* PWR;
    DI void fused(const f32x4 (&acc)[2][2][4][2], const pg::Unit& u, int wr, int wc, int fr, int fq, LAS unsigned char* lds, int wid, int lane) const {
        LAS float* E = (LAS float*)lds;
        EPI_ROWS(ai, m) { const int r = ai * 128 + wr * 64 + m * 16 + fr;
#pragma unroll
            for (int n = 0; n < 2; ++n) *(LAS f32x4*)(E + r * 132 + wc * 32 + 16 * n + 4 * fq) = acc[ai][0][m][n]; }
        __syncthreads();
        const int t = wid * 64 + lane;
        if (t < 128) { const int bl = t >> 6, n = t & 63, g = u.z;
            const float ar = PWR[((g * 33 + 32) * 64 + n) * 2], ai_ = PWR[((g * 33 + 32) * 64 + n) * 2 + 1];
            float hr = 0.f, hi = 0.f;
            bf16_t* up = U + (size_t)g * UG_STRIDE + (size_t)(u.pm * 256 + bl * 128) * 640 + 512 + 2 * n;
            for (int c = 0; c < 128; ++c) {
                *(unsigned*)(up + (size_t)c * 640) = pk2(hr, hi);
                const f32x2 e = *(const LAS f32x2*)(E + (bl * 128 + c) * 132 + 2 * n);
                const float nr = ar * hr - ai_ * hi + e.x, ni = ar * hi + ai_ * hr + e.y; hr = nr; hi = ni; }
        }
        __syncthreads();
    }
};
struct EpiSsmY {
    static constexpr bool PERM = true, AFTER_DRAIN = false;
    bf16_t* YG;
    DI void operator()(const f32x4 (&acc)[2][2][4][2], const pg::Unit& u, int wr, int wc, int fr, int fq) const {
        const unsigned lo = (unsigned)((fr * 32 + (fq >> 1)) * 512 + (fq & 1) * 8) * 2u;
        EPI_ROWS(ai, m) { const int ru = u.pm * 256 + ai * 128 + wr * 64 + m * 16;
#pragma unroll
            for (int bj = 0; bj < 2; ++bj) { const int cu = u.pn * 256 + bj * 128 + wc * 32;
                f32x4 v0 = acc[ai][bj][m][0], v1 = acc[ai][bj][m][1];
#pragma unroll
                for (int j = 0; j < 4; ++j) { v0[j] = gelu_tanh_f(v0[j]); v1[j] = gelu_tanh_f(v1[j]); }
                st16(YG + ((size_t)ru * 32 + (cu >> 4)) * 512 + u.z * 16, lo, pack8(v0, v1)); } }
    }
};
struct EpiSexp {
    static constexpr bool PERM = true, AFTER_DRAIN = false;
    bf16_t* PB; float* RS;
    DI void operator()(const f32x4 (&acc)[2][2][4][2], const pg::Unit& u, int wr, int wc, int fr, int fq) const {
        const unsigned lo = (unsigned)(fr * 1024 + fq * 8) * 2u;
        EPI_ROWS(ai, m) { const size_t ru = (size_t)(u.row0 + ai * 128 + wr * 64 + m * 16); float s = 0.f;
#pragma unroll
            for (int bj = 0; bj < 2; ++bj) { f32x4 v0 = acc[ai][bj][m][0], v1 = acc[ai][bj][m][1];
#pragma unroll
                for (int j = 0; j < 4; ++j) { v0[j] = fast_exp2(fminf(v0[j], 100.f)); v1[j] = fast_exp2(fminf(v1[j], 100.f)); }
                const u32x4 w = pack8(v0, v1);
                s += (bflo(w.x) + bfhi(w.x)) + (bflo(w.y) + bfhi(w.y)) + (bflo(w.z) + bfhi(w.z)) + (bflo(w.w) + bfhi(w.w));
                st16(PB + ru * 1024 + u.col0 + bj * 128 + wc * 32, lo, w); }
            s += __shfl_xor(s, 16); s += __shfl_xor(s, 32);
            if (fq == 0) *(float*)((char*)(RS + (ru * 4 + (u.col0 >> 8)) * 4 + wc) + (unsigned)fr * 64u) = s; }
    }
};
struct EpiPv {
    static constexpr bool PERM = true, AFTER_DRAIN = false;
    bf16_t* XO; const float* RS;
    DI void operator()(const f32x4 (&acc)[2][2][4][2], const pg::Unit& u, int wr, int wc, int fr, int fq) const {
        const unsigned lo = (unsigned)(fr * 1024 + fq * 8) * 2u;
        EPI_ROWS(ai, m) { const size_t ru = (size_t)(u.row0 + ai * 128 + wr * 64 + m * 16);
            const f32x4 rs = ld16f(RS + (ru * 4 + (u.col0 >> 8)) * 4, (unsigned)fr * 64u); const float inv = 1.f / ((rs[0] + rs[1]) + (rs[2] + rs[3]));
#pragma unroll
            for (int bj = 0; bj < 2; ++bj) st16(XO + ru * 1024 + u.col0 + bj * 128 + wc * 32, lo, pack8(acc[ai][bj][m][0] * inv, acc[ai][bj][m][1] * inv)); }
    }
};
struct EpiMoeDown {
    static constexpr bool PERM = true, AFTER_DRAIN = false;
    bf16_t* Y; const float* wslot;
    DI void operator()(const f32x4 (&acc)[2][2][4][2], const pg::Unit& u, int wr, int wc, int fr, int fq) const {
        const unsigned lo = (unsigned)(fr * 1024 + fq * 8) * 2u;
        EPI_ROWS(ai, m) { const size_t ru = (size_t)(u.row0 + ai * 128 + wr * 64 + m * 16); const float w = *(const float*)((const char*)(wslot + ru) + (unsigned)fr * 4u);
#pragma unroll
            for (int bj = 0; bj < 2; ++bj) st16(Y + ru * 1024 + u.col0 + bj * 128 + wc * 32, lo, pack8(acc[ai][bj][m][0] * w, acc[ai][bj][m][1] * w)); }
    }
};
}
namespace fp {
constexpr int CW_BARBASE = 65536, CW_BARSTRIDE = 4096;
constexpr size_t WS_WL = WS_FAST_END;
constexpr size_t WS_FAST_END2 = al(WS_WL + (size_t)NE * NTOK * 4);

struct Args { const float* in[35]; float* out; unsigned char* ws; int ph_lo, ph_hi, bar_region, pad; };

struct Ctx { int tid, lane, wave, G, vcu, gw, NGW, gt, NGT; LAS unsigned char* lds; };

template <int MAP> DI int map_row(int n0, int F) { if (MAP == 0) return n0; return n0 < F ? (n0 / 128) * 256 + (n0 % 128) : ((n0 - F) / 128) * 256 + 128 + ((n0 - F) % 128); }
template <int MAP> DI void transpose_item(const float* W, int K, int N, bf16_t* WT, int dld, int dcol0, int drow0, int F, LAS float* scr, int item, int lane) {
    const int nblk = N / 32, kb = item / nblk, nb = item % nblk, k0 = 64 * kb, n0 = 32 * nb;
#pragma unroll 8
    for (int i = 0; i < 32; ++i) { const int kk = 2 * i + (lane >> 5); scr[kk * 33 + (lane & 31)] = W[(size_t)(k0 + kk) * N + n0 + (lane & 31)]; }
    asm volatile("s_waitcnt lgkmcnt(0)" ::: "memory");
    const int c = lane & 7, dr = drow0 + map_row<MAP>(n0, F);
#pragma unroll
    for (int j = 0; j < 4; ++j) { const int n = (lane >> 3) + 8 * j; const LAS float* s = scr + (8 * c) * 33 + n;
        u32x4 o; o.x = pk2(s[0 * 33], s[1 * 33]); o.y = pk2(s[2 * 33], s[3 * 33]); o.z = pk2(s[4 * 33], s[5 * 33]); o.w = pk2(s[6 * 33], s[7 * 33]);
        *(u32x4*)(WT + (size_t)(dr + n) * dld + dcol0 + k0 + 8 * c) = o; }
    asm volatile("s_waitcnt lgkmcnt(0)" ::: "memory");
}
template <int MAP> DI void transpose_mats(const Ctx& C, const float* src, size_t sstr, int nmat, int K, int N, bf16_t* dst, size_t dstr, int F) {
    LAS float* scr = (LAS float*)(C.lds + C.wave * 16384);
    const int per = (K / 64) * (N / 32);
    for (int it = C.gw; it < nmat * per; it += C.NGW) { const int mt = it / per, r = it % per; transpose_item<MAP>(src + (size_t)mt * sstr, K, N, dst + (size_t)mt * dstr, K, 0, 0, F, scr, r, C.lane); }
}
DI void reduce_2pi(double ang, float& s, float& c) { const double k = rint(ang * 0.15915494309189535); const float r = (float)(ang - k * 6.283185307179586); sincosf(r, &s, &c); }

DI void prologue_a(const Ctx& C, const Args& a) {
    unsigned char* ws = a.ws;
    transpose_mats<0>(C, a.in[2], (size_t)DM * INW, NL, DM, INW, (bf16_t*)(ws + WS_WIN), (size_t)INW * DM, 0);
    transpose_mats<1>(C, a.in[13], (size_t)512 * 1024, NL, 512, 1024, (bf16_t*)(ws + WS_WGLU), (size_t)1024 * 512, 512);
    for (int b = 0; b < 3; ++b) transpose_mats<0>(C, a.in[16 + b], (size_t)512 * 1024, NL, 512, 1024, (bf16_t*)(ws + WS_WBR) + (size_t)b * 1024 * 512, (size_t)3 * 1024 * 512, 0);
    transpose_mats<0>(C, a.in[19], (size_t)DM * DM, NL, DM, DM, (bf16_t*)(ws + WS_WO), (size_t)DM * DM, 0);
    transpose_mats<0>(C, a.in[22], (size_t)DM * DM, NL, DM, DM, (bf16_t*)(ws + WS_WQ), (size_t)DM * DM, 0);
    transpose_mats<0>(C, a.in[23], (size_t)DM * 2048, NL, DM, 2048, (bf16_t*)(ws + WS_WKV), (size_t)2048 * DM, 0);
    transpose_mats<0>(C, a.in[24], (size_t)DM * DM, NL, DM, DM, (bf16_t*)(ws + WS_WXO), (size_t)DM * DM, 0);
    transpose_mats<1>(C, a.in[27], (size_t)DM * 2 * DFF, 2, DM, 2 * DFF, (bf16_t*)(ws + WS_WGU), (size_t)2 * DFF * DM, DFF);
    transpose_mats<0>(C, a.in[28], (size_t)DFF * DM, 2, DFF, DM, (bf16_t*)(ws + WS_WDN), (size_t)DM * DFF, 0);
    transpose_mats<1>(C, a.in[31], (size_t)DM * 2 * DFFE, 2 * NE, DM, 2 * DFFE, (bf16_t*)(ws + WS_MGU), (size_t)2 * DFFE * DM, DFFE);
    transpose_mats<0>(C, a.in[32], (size_t)DFFE * DM, 2 * NE, DFFE, DM, (bf16_t*)(ws + WS_MDN), (size_t)DM * DFFE, 0);
    { LAS float* scr = (LAS float*)(C.lds + C.wave * 16384);
      for (int it = C.gw; it < NL * 4 * 8; it += C.NGW) { const int lg = it >> 3, r = it & 7, L = lg >> 2, g = lg & 3;
          transpose_item<0>(a.in[14] + (size_t)lg * 128 * 128, 128, 128, (bf16_t*)(ws + WS_WPOOL) + (size_t)L * 512 * 512, 512, g * 128, g * 128, 0, scr, r, C.lane); }
      for (int p = C.gt; p < NL * 512 * 64; p += C.NGT) { const int L = p >> 15, n = (p >> 6) & 511, k8 = p & 63;
          if ((n >> 7) != (k8 >> 4)) *(u32x4*)((bf16_t*)(ws + WS_WPOOL) + ((size_t)L * 512 + n) * 512 + k8 * 8) = (u32x4){0u, 0u, 0u, 0u}; } }
    for (int p = C.gt; p < SEQ * 8; p += C.NGT) { const int pos = p >> 3, i = p & 7; const float inv = powf(500000.0f, -(float)i / 8.0f), ang = (float)pos * inv; float s, c; sincosf(ang, &s, &c);
        float* r = (float*)(ws + WS_ROPE) + (size_t)pos * 16; r[i] = c; r[8 + i] = s; }
    for (int p = C.gt; p < 2048 * 1024 / 8; p += C.NGT) { const f32x4 v0 = *(const f32x4*)(a.in[1] + (size_t)p * 8), v1 = *(const f32x4*)(a.in[1] + (size_t)p * 8 + 4); *(u32x4*)((bf16_t*)(ws + WS_MEMB) + (size_t)p * 8) = pack8(v0, v1); }
    for (int p = C.gt; p < NTOK * DM / 8; p += C.NGT) { const f32x4 v0 = *(const f32x4*)(a.in[0] + (size_t)p * 8), v1 = *(const f32x4*)(a.in[0] + (size_t)p * 8 + 4); *(u32x4*)((bf16_t*)(ws + WS_XB) + (size_t)p * 8) = pack8(v0, v1); }
    { LAS float* W = (LAS float*)(C.lds + C.wave * 16384);
      for (int it = C.gw; it < NL * 32 * 33; it += C.NGW) { const int L = it / (32 * 33), r = it % (32 * 33), g = r / 33, tau = r % 33, n = C.lane;
          const float ar = a.in[5][(L * 32 + g) * 64 + n], ai = a.in[6][(L * 32 + g) * 64 + n], dt = expf(a.in[7][L * 32 + g]);
          float pr, pi; { const float mag = expf((float)tau * dt * ar); float s, c; reduce_2pi((double)tau * (double)dt * (double)ai, s, c); pr = mag * c; pi = mag * s; }
          float* pw = (float*)(ws + WS_PWR + (size_t)L * SZ_PWR) + ((size_t)(g * 33 + tau) * 64 + n) * 2; pw[0] = pr; pw[1] = pi;
          if (tau < 32) {
              float abr, abi; { const float mag = expf(dt * ar); float s, c; reduce_2pi((double)dt * (double)ai, s, c); abr = mag * c; abi = mag * s; }
              const float inv = 1.f / (ar * ar + ai * ai), nr = abr - 1.f, ni = abi, fr = (nr * ar + ni * ai) * inv, fi = (ni * ar - nr * ai) * inv;
              const float* bre = a.in[8] + ((size_t)(L * 32 + g) * 64 + n) * 16; const float* bim = a.in[9] + ((size_t)(L * 32 + g) * 64 + n) * 16;
              float* bb = (float*)(ws + WS_BBAR + (size_t)L * SZ_BBAR) + ((size_t)g * 64 + n) * 32;
#pragma unroll
              for (int j = 0; j < 16; ++j) { const float br = bre[j], bi = bim[j], xr = fr * br - fi * bi, xi = fr * bi + fi * br;
                  if (tau == 0) { bb[2 * j] = xr; bb[2 * j + 1] = xi; }
                  W[(n * 16 + j) * 2] = pr * xr - pi * xi; W[(n * 16 + j) * 2 + 1] = pr * xi + pi * xr; }
              asm volatile("s_waitcnt lgkmcnt(0)" ::: "memory");
              const float* cre = a.in[10] + (size_t)(L * 32 + g) * 16 * 64; const float* cim = a.in[11] + (size_t)(L * 32 + g) * 16 * 64;
              float* kg = (float*)(ws + WS_KG + (size_t)L * SZ_KG) + (size_t)(g * 32 + tau) * 256;
#pragma unroll
              for (int q = 0; q < 4; ++q) { const int o = C.lane + 64 * q, p = o >> 4, j = o & 15; float s = 0.f;
                  for (int k = 0; k < 64; ++k) s += cre[p * 64 + k] * W[(k * 16 + j) * 2] - cim[p * 64 + k] * W[(k * 16 + j) * 2 + 1];
                  if (tau == 0 && p == j) s += a.in[12][L * 512 + g * 16 + p];
                  kg[o] = s; }
              asm volatile("s_waitcnt lgkmcnt(0)" ::: "memory");
          } } }
}
DI void prologue_b_tables(const Ctx& C, const Args& a) {
    unsigned char* ws = a.ws;
    for (int p = C.gt; p < NL * 32 * 512 * 80; p += C.NGT) { const int c8 = p % 80, rr = p / 80, r = rr & 511, lg = rr >> 9, L = lg >> 5, g = lg & 31, t = r >> 4, pp = r & 15;
        f32x4 v0 = {0.f, 0.f, 0.f, 0.f}, v1 = {0.f, 0.f, 0.f, 0.f};
        if (c8 < 64) { const int s = c8 >> 1, j0 = (c8 & 1) * 8;
            if (s <= t) { const float* kg = (const float*)(ws + WS_KG + (size_t)L * SZ_KG) + ((size_t)(g * 32 + (t - s)) * 16 + pp) * 16 + j0; v0 = *(const f32x4*)kg; v1 = *(const f32x4*)(kg + 4); } }
        else { const int n0 = (c8 - 64) * 4; const float* cre = a.in[10] + ((size_t)(L * 32 + g) * 16 + pp) * 64 + n0; const float* cim = a.in[11] + ((size_t)(L * 32 + g) * 16 + pp) * 64 + n0;
            const float* pw = (const float*)(ws + WS_PWR + (size_t)L * SZ_PWR) + ((size_t)(g * 33 + t + 1) * 64 + n0) * 2;
            float o[8];
#pragma unroll
            for (int i = 0; i < 4; ++i) { const float cr = cre[i], ci = cim[i], pr = pw[2 * i], pi = pw[2 * i + 1]; o[2 * i] = cr * pr - ci * pi; o[2 * i + 1] = -(cr * pi + ci * pr); }
            v0 = (f32x4){o[0], o[1], o[2], o[3]}; v1 = (f32x4){o[4], o[5], o[6], o[7]}; }
        *(u32x4*)((bf16_t*)(ws + WS_MT + (size_t)L * SZ_MT) + ((size_t)g * 512 + r) * 640 + c8 * 8) = pack8(v0, v1); }
    for (int p = C.gt; p < NL * 32 * 256 * 64; p += C.NGT) { const int c8 = p & 63, n2 = (p >> 6) & 255, lg = p >> 14, L = lg >> 5, g = lg & 31;
        f32x4 v0 = {0.f, 0.f, 0.f, 0.f}, v1 = {0.f, 0.f, 0.f, 0.f};
        if (n2 < 128) { const int n = n2 >> 1, im = n2 & 1, s = c8 >> 1, j0 = (c8 & 1) * 8;
            const float* pw = (const float*)(ws + WS_PWR + (size_t)L * SZ_PWR) + ((size_t)(g * 33 + (31 - s)) * 64 + n) * 2; const float pr = pw[0], pi = pw[1];
            const float* bb = (const float*)(ws + WS_BBAR + (size_t)L * SZ_BBAR) + ((size_t)g * 64 + n) * 32 + j0 * 2;
            float o[8];
#pragma unroll
            for (int i = 0; i < 8; ++i) { const float xr = bb[2 * i], xi = bb[2 * i + 1]; o[i] = im ? (pr * xi + pi * xr) : (pr * xr - pi * xi); }
            v0 = (f32x4){o[0], o[1], o[2], o[3]}; v1 = (f32x4){o[4], o[5], o[6], o[7]}; }
        *(u32x4*)((bf16_t*)(ws + WS_PT + (size_t)L * SZ_PT) + ((size_t)g * 256 + n2) * 512 + c8 * 8) = pack8(v0, v1); }
}

template <int MODE, bool ROUTE>
DI void ln_phase(const Ctx& C, const float* T, const float* X, const float* gam, const float* bet, float* XFo, bf16_t* XBo,
                 const bf16_t* Y, const int* rte, const int* rtp, const unsigned* cntw,
                 const float* wr, const float* brt, int* rte_o, int* rtp_o, float* rtw_o, int* src_o, float* wl_o, unsigned* cnt_o) {
    f32x4 gg[4], bb[4];
#pragma unroll
    for (int j = 0; j < 4; ++j) { gg[j] = *(const f32x4*)(gam + j * 256 + C.lane * 4); bb[j] = *(const f32x4*)(bet + j * 256 + C.lane * 4); }
    int base[8];
    if (MODE == 1) { int acc = 0;
#pragma unroll
        for (int e = 0; e < 8; ++e) { base[e] = acc; acc += (int)((cntw[e * 64] + 255u) & ~255u); } }
    LAS float* wT = (LAS float*)C.lds;
    if (ROUTE) { for (int i = C.tid; i < 8192; i += 512) { const int k = i >> 3, e = i & 7; wT[e * 1024 + k] = wr[i]; } __syncthreads(); }
    for (int row = C.gw; row < NTOK; row += C.NGW) {
        f32x4 v[4]; float s = 0.f;
        if (MODE == 0) {
#pragma unroll
            for (int j = 0; j < 4; ++j) v[j] = *(const f32x4*)(T + (size_t)row * 1024 + j * 256 + C.lane * 4);
        } else {
            const int e0 = rte[row * 2], e1 = rte[row * 2 + 1], p0 = rtp[row * 2], p1 = rtp[row * 2 + 1];
            int b0 = 0, b1 = 0;
#pragma unroll
            for (int e = 0; e < 8; ++e) { b0 = e == e0 ? base[e] : b0; b1 = e == e1 ? base[e] : b1; }
            const bf16_t* ya = Y + (size_t)(b0 + p0) * 1024; const bf16_t* yb = Y + (size_t)(b1 + p1) * 1024;
#pragma unroll
            for (int j = 0; j < 4; ++j) { const f32x4 x = *(const f32x4*)(X + (size_t)row * 1024 + j * 256 + C.lane * 4);
                const u32x2 wa = *(const u32x2*)(ya + j * 256 + C.lane * 4), wb = *(const u32x2*)(yb + j * 256 + C.lane * 4);
                v[j][0] = ALPHA * x[0] + bflo(wa.x) + bflo(wb.x); v[j][1] = ALPHA * x[1] + bfhi(wa.x) + bfhi(wb.x); v[j][2] = ALPHA * x[2] + bflo(wa.y) + bflo(wb.y); v[j][3] = ALPHA * x[3] + bfhi(wa.y) + bfhi(wb.y); }
        }
#pragma unroll
        for (int j = 0; j < 4; ++j) s += (v[j][0] + v[j][1]) + (v[j][2] + v[j][3]);
        const float mean = wave_sum(s) * (1.f / 1024.f); float q = 0.f;
#pragma unroll
        for (int j = 0; j < 4; ++j) { v[j] = v[j] - mean; q += (v[j][0] * v[j][0] + v[j][1] * v[j][1]) + (v[j][2] * v[j][2] + v[j][3] * v[j][3]); }
        const float rstd = rsqrtf(wave_sum(q) * (1.f / 1024.f) + LN_EPS);
#pragma unroll
        for (int j = 0; j < 4; ++j) { v[j] = v[j] * rstd * gg[j] + bb[j];
            *(f32x4*)(XFo + (size_t)row * 1024 + j * 256 + C.lane * 4) = v[j];
            u32x2 w; w.x = pk2(v[j][0], v[j][1]); w.y = pk2(v[j][2], v[j][3]); *(u32x2*)(XBo + (size_t)row * 1024 + j * 256 + C.lane * 4) = w; }
        if (ROUTE) {
            float lg[8];
#pragma unroll
            for (int e = 0; e < 8; ++e) { float t = 0.f;
#pragma unroll
                for (int j = 0; j < 4; ++j) { const f32x4 w = *(const LAS f32x4*)(wT + e * 1024 + j * 256 + C.lane * 4); t += (v[j][0] * w[0] + v[j][1] * w[1]) + (v[j][2] * w[2] + v[j][3] * w[3]); }
                lg[e] = wave_sum(t) + brt[e]; }
            int i1 = 0; float v1 = lg[0];
#pragma unroll
            for (int e = 1; e < 8; ++e) if (lg[e] > v1) { v1 = lg[e]; i1 = e; }
            int i2 = 0; float v2 = -3.0e38f;
#pragma unroll
            for (int e = 0; e < 8; ++e) if (e != i1 && lg[e] > v2) { v2 = lg[e]; i2 = e; }
            const float w2 = 1.f / (1.f + expf(v1 - v2)), w1 = 1.f - w2;
            if (C.lane == 0) {
                const int p1 = (int)__hip_atomic_fetch_add(cnt_o + i1 * 64, 1u, RLX_AGENT), p2 = (int)__hip_atomic_fetch_add(cnt_o + i2 * 64, 1u, RLX_AGENT);
                rte_o[row * 2] = i1; rte_o[row * 2 + 1] = i2; rtp_o[row * 2] = p1; rtp_o[row * 2 + 1] = p2; rtw_o[row * 2] = w1; rtw_o[row * 2 + 1] = w2;
                src_o[(size_t)i1 * NTOK + p1] = row; src_o[(size_t)i2 * NTOK + p2] = row; wl_o[(size_t)i1 * NTOK + p1] = w1; wl_o[(size_t)i2 * NTOK + p2] = w2;
            }
        }
    }
    if (ROUTE) __syncthreads();
}

DI void pool_phase(const Ctx& C, const bf16_t* UP, bf16_t* PO) {
    for (int p = C.gt; p < NTOK * 64; p += C.NGT) { const int row = p >> 6, c8 = p & 63, w = 2 << (c8 >> 4), t = row & (SEQ - 1), cnt = t + 1 < w ? t + 1 : w;
        float s[8], u0[8];
#pragma unroll
        for (int i = 0; i < 8; ++i) s[i] = 0.f;
        for (int j = 0; j < cnt; ++j) { const u32x4 x = *(const u32x4*)(UP + (size_t)(row - j) * 512 + c8 * 8);
            const float f[8] = {bflo(x.x), bfhi(x.x), bflo(x.y), bfhi(x.y), bflo(x.z), bfhi(x.z), bflo(x.w), bfhi(x.w)};
#pragma unroll
            for (int i = 0; i < 8; ++i) { s[i] += f[i]; if (j == 0) u0[i] = f[i]; } }
        const float inv = 1.f / (float)cnt; f32x4 v0, v1;
#pragma unroll
        for (int i = 0; i < 4; ++i) { v0[i] = s[i] * inv - u0[i]; v1[i] = s[4 + i] * inv - u0[4 + i]; }
        *(u32x4*)(PO + (size_t)row * 512 + c8 * 8) = pack8(v0, v1); }
}

DI void moe_gather_phase(const Ctx& C, const unsigned* cntw, const int* src, const float* wl, const bf16_t* XB, bf16_t* XG, float* WSLOT) {
    int base[9]; { int acc = 0;
#pragma unroll
        for (int e = 0; e < 8; ++e) { base[e] = acc; acc += (int)((cntw[e * 64] + 255u) & ~255u); } base[8] = acc; }
    for (int s = C.gw; s < base[8]; s += C.NGW) {
        int e = 0;
#pragma unroll
        for (int k = 1; k < 8; ++k) e = s >= base[k] ? k : e;
        int be = 0;
#pragma unroll
        for (int k = 0; k < 8; ++k) be = k == e ? base[k] : be;
        const int pos = s - be; const bool valid = pos < (int)cntw[e * 64];
        u32x4 v0 = {0u, 0u, 0u, 0u}, v1 = {0u, 0u, 0u, 0u}; float w = 0.f;
        if (valid) { const int r = src[(size_t)e * NTOK + pos]; w = wl[(size_t)e * NTOK + pos];
            v0 = *(const u32x4*)(XB + (size_t)r * 1024 + C.lane * 16); v1 = *(const u32x4*)(XB + (size_t)r * 1024 + C.lane * 16 + 8); }
        *(u32x4*)(XG + (size_t)s * 1024 + C.lane * 16) = v0; *(u32x4*)(XG + (size_t)s * 1024 + C.lane * 16 + 8) = v1;
        if (C.lane == 0) WSLOT[s] = w;
    }
}

constexpr int KS_STRIDE = 72, VT_STRIDE = 264;
DI void swa_phase(const Ctx& C, const bf16_t* Q, const bf16_t* KK, const bf16_t* VV, const float* sinks, bf16_t* AO) {
    LAS bf16_t* Ks = (LAS bf16_t*)C.lds; LAS bf16_t* Vt = Ks + 256 * KS_STRIDE;
    const int r = C.lane & 31, h = C.lane >> 5;
    for (int un = blockIdx.x; un < 8 * 2 * 32; un += C.G) {
        const int qb = un & 31, kvh = (un >> 5) & 1, b = un >> 6;
        const int k0 = qb * 128 - 128;
        __syncthreads();
#pragma unroll
        for (int i = 0; i < 4; ++i) { const int p = C.tid + 512 * i, key = p >> 3, part = p & 7, pos = k0 + key;
            u32x4 kv = {0u, 0u, 0u, 0u}, vv = {0u, 0u, 0u, 0u};
            if (pos >= 0) { const size_t g = (size_t)(b * SEQ + pos) * 128 + kvh * 64 + part * 8; kv = *(const u32x4*)(KK + g); vv = *(const u32x4*)(VV + g); }
            *(LAS u32x4*)(Ks + key * KS_STRIDE + part * 8) = kv;
            const unsigned vw[4] = {vv.x, vv.y, vv.z, vv.w};
#pragma unroll
            for (int j = 0; j < 4; ++j) { Vt[(part * 8 + 2 * j) * VT_STRIDE + key] = (bf16_t)(vw[j] & 0xffffu); Vt[(part * 8 + 2 * j + 1) * VT_STRIDE + key] = (bf16_t)(vw[j] >> 16); } }
        __syncthreads();
#pragma unroll 1
        for (int rep = 0; rep < 2; ++rep) {
            const int it = C.wave + 8 * rep, g4 = it >> 2, q0 = (it & 3) * 32, head = kvh * 4 + g4;
            const size_t tok = (size_t)b * SEQ + qb * 128 + q0 + r;
            bf16x8 qf[4];
#pragma unroll
            for (int ks = 0; ks < 4; ++ks) qf[ks] = *(const bf16x8*)(Q + tok * 512 + head * 64 + ks * 16 + h * 8);
            const float sink2 = sinks[head] * LOG2E;
            float m = sink2, l = 1.f;
            f32x16 o0, o1;
#pragma unroll
            for (int i = 0; i < 16; ++i) { o0[i] = 0.f; o1[i] = 0.f; }
#pragma unroll 1
            for (int kb = 0; kb < 5; ++kb) {
                f32x16 x;
#pragma unroll
                for (int i = 0; i < 16; ++i) x[i] = 0.f;
                const LAS bf16_t* kp = Ks + (q0 + kb * 32 + r) * KS_STRIDE + h * 8;
#pragma unroll
                for (int ks = 0; ks < 4; ++ks) { const bf16x8 kf = *(const LAS bf16x8*)(kp + ks * 16); x = __builtin_amdgcn_mfma_f32_32x32x16_bf16(kf, qf[ks], x, 0, 0, 0); }
                float bm = -1.0e30f; const int relb = 128 + r - kb * 32 - 4 * h, posb = k0 + q0 + kb * 32 + 4 * h;
#pragma unroll
                for (int i = 0; i < 16; ++i) { const int cr = (i & 3) + 8 * (i >> 2); const int rel = relb - cr; const bool ok = rel >= 0 && rel < 128 && (posb + cr) >= 0;
                    x[i] = ok ? x[i] : -1.0e30f; bm = fmaxf(bm, x[i]); }
                bm = fmaxf(bm, __shfl_xor(bm, 32));
                const float mn = fmaxf(m, bm), sc = fast_exp2(m - mn); m = mn;
                float ps = 0.f;
#pragma unroll
                for (int i = 0; i < 16; ++i) { x[i] = fast_exp2(x[i] - mn); ps += x[i]; }
                ps += __shfl_xor(ps, 32);
                l = l * sc + ps;
#pragma unroll
                for (int i = 0; i < 16; ++i) { o0[i] *= sc; o1[i] *= sc; }
#pragma unroll
                for (int s2 = 0; s2 < 2; ++s2) { u32x4 pw; pw.x = pk2(x[8 * s2], x[8 * s2 + 1]); pw.y = pk2(x[8 * s2 + 2], x[8 * s2 + 3]); pw.z = pk2(x[8 * s2 + 4], x[8 * s2 + 5]); pw.w = pk2(x[8 * s2 + 6], x[8 * s2 + 7]);
                    const bf16x8 pf = __builtin_bit_cast(bf16x8, pw);
                    const LAS bf16_t* vp = Vt + r * VT_STRIDE + q0 + kb * 32 + 16 * s2 + 4 * h;
                    { const s16x4 lo = *(const LAS s16x4*)vp, hi = *(const LAS s16x4*)(vp + 8); const bf16x8 vf = __builtin_shufflevector(lo, hi, 0, 1, 2, 3, 4, 5, 6, 7); o0 = __builtin_amdgcn_mfma_f32_32x32x16_bf16(vf, pf, o0, 0, 0, 0); }
                    { const s16x4 lo = *(const LAS s16x4*)(vp + 32 * VT_STRIDE), hi = *(const LAS s16x4*)(vp + 32 * VT_STRIDE + 8); const bf16x8 vf = __builtin_shufflevector(lo, hi, 0, 1, 2, 3, 4, 5, 6, 7); o1 = __builtin_amdgcn_mfma_f32_32x32x16_bf16(vf, pf, o1, 0, 0, 0); } }
            }
            const float inv = 1.f / l;
            bf16_t* ao = AO + tok * 512 + head * 64 + 4 * h;
#pragma unroll
            for (int g = 0; g < 4; ++g) { u32x2 w; w.x = pk2(o0[4 * g] * inv, o0[4 * g + 1] * inv); w.y = pk2(o0[4 * g + 2] * inv, o0[4 * g + 3] * inv); *(u32x2*)(ao + 8 * g) = w; }
#pragma unroll
            for (int g = 0; g < 4; ++g) { u32x2 w; w.x = pk2(o1[4 * g] * inv, o1[4 * g + 1] * inv); w.y = pk2(o1[4 * g + 2] * inv, o1[4 * g + 3] * inv); *(u32x2*)(ao + 32 + 8 * g) = w; }
        }
    }
    __syncthreads();
}

struct KvOrder {
    const char* MEMB; const char* WKV; int G, c;
    DI bool next(int i, pg::Unit& u) const { const int q = i * G + c; if (q >= 256) return false; const int L = q >> 6, r = q & 63; const char* wkv = WKV + (size_t)L * SZ_WKV;
        if (r < 32) { u.pm = r >> 2; u.pn = r & 3; u.z = 0; u.row0 = L * 2048 + u.pm * 256; u.col0 = u.pn * 256; u.a = MEMB + (size_t)u.pm * 256 * 2048; u.b = wkv + (size_t)u.pn * 256 * 2048; }
        else { const int bb = (r - 32) >> 2; u.pm = (r - 32) & 3; u.pn = 0; u.z = 1; u.row0 = (L * 8 + bb) * 1024 + u.pm * 256; u.col0 = 0; u.a = wkv + (size_t)(1024 + u.pm * 256) * 2048; u.b = MEMB + (size_t)bb * 256 * 2048; }
        return true; }
};
struct EpiKv {
    static constexpr bool PERM = true, AFTER_DRAIN = false;
    bf16_t *KM, *VT;
    DI void operator()(const f32x4 (&acc)[2][2][4][2], const pg::Unit& u, int wr, int wc, int fr, int fq) const {
        bf16_t* O = u.z ? VT : KM; const int ldc = u.z ? 256 : 1024; const unsigned lo = (unsigned)(fr * ldc + fq * 8) * 2u;
        EPI_ROWS(ai, m) { bf16_t* ub = O + (size_t)(u.row0 + ai * 128 + wr * 64 + m * 16) * ldc + u.col0 + wc * 32;
#pragma unroll
            for (int bj = 0; bj < 2; ++bj) st16(ub + bj * 128, lo, pack8(acc[ai][bj][m][0], acc[ai][bj][m][1])); }
    }
};
struct SsmEOrder {
    const char* U; const char* PT; int G, c;
    DI bool next(int i, pg::Unit& u) const { const int q = i * G + c; if (q >= 128) return false; u.z = q >> 2; u.pm = q & 3; u.pn = 0; u.row0 = u.pm * 256; u.col0 = 0;
        u.a = U + ((size_t)u.z * UG_STRIDE + (size_t)u.pm * 256 * 640) * 2; u.b = PT + (size_t)u.z * 256 * 512 * 2; return true; }
};
struct SsmYOrder {
    const char* U; const char* MT; int G, c;
    DI bool next(int i, pg::Unit& u) const { const int q = i * G + c; if (q >= 256) return false; u.z = q >> 3; u.pm = (q >> 1) & 3; u.pn = q & 1; u.row0 = u.pm * 256; u.col0 = u.pn * 256;
        u.a = U + ((size_t)u.z * UG_STRIDE + (size_t)u.pm * 256 * 640) * 2; u.b = MT + ((size_t)u.z * 512 + u.pn * 256) * 640 * 2; return true; }
};
struct XsOrder {
    const char* XQ; const char* KM; int G, c;
    DI bool next(int i, pg::Unit& u) const { const int q = i * G + c; if (q >= 512) return false; const int bh = q >> 4, b = bh >> 2, hh = bh & 3; u.pm = q & 15; u.pn = 0; u.z = bh; u.row0 = b * SEQ + u.pm * 256; u.col0 = hh * 256;
        u.a = XQ + ((size_t)u.row0 * 1024 + hh * 256) * 2; u.b = KM + ((size_t)b * 256 * 1024 + hh * 256) * 2; return true; }
};
struct XpvOrder {
    const char* PB; const char* VT; int G, c;
    DI bool next(int i, pg::Unit& u) const { const int q = i * G + c; if (q >= 512) return false; const int bh = q >> 4, b = bh >> 2, hh = bh & 3; u.pm = q & 15; u.pn = 0; u.z = bh; u.row0 = b * SEQ + u.pm * 256; u.col0 = hh * 256;
        u.a = PB + ((size_t)u.row0 * 1024 + hh * 256) * 2; u.b = VT + ((size_t)b * 1024 + hh * 256) * 256 * 2; return true; }
};
struct MoeOrder {
    const char* A; const char* Bt; size_t astep, bstep, estride; int nM, nN, G, c; int tb[9];
    DI void init(const void* A_, const void* Bt_, int lda, int ldb, int N, size_t estride_, const unsigned* cntw, int G_, int c_) { A = (const char*)A_; Bt = (const char*)Bt_; astep = (size_t)256 * lda * 2; bstep = (size_t)256 * ldb * 2; estride = estride_; nN = N / 256; G = G_; c = c_;
        int acc = 0;
#pragma unroll
        for (int e = 0; e < 8; ++e) { tb[e] = acc; acc += (int)((__builtin_amdgcn_readfirstlane(cntw[e * 64]) + 255u) >> 8); } tb[8] = acc; nM = acc; }
    DI bool next(int i, pg::Unit& u) const { if (!pg::tile_of(i, G, c, nM, nN, u.pm, u.pn)) return false; int e = 0;
#pragma unroll
        for (int k = 1; k < 8; ++k) e = u.pm >= tb[k] ? k : e;
        u.z = e; u.row0 = u.pm * 256; u.col0 = u.pn * 256; u.a = A + (size_t)u.pm * astep; u.b = Bt + (size_t)e * estride + (size_t)u.pn * bstep; return true; }
};
}
namespace fp {
constexpr int PH_PER_LAYER = 16, N_PHASES = 2 + NL * PH_PER_LAYER;

__global__ void __launch_bounds__(512, 2) fwd(Args args) {
    extern __shared__ __attribute__((aligned(16))) unsigned char lds_raw[];
    Ctx C0; Ctx& C_ = C0; C_.lds = (LAS unsigned char*)lds_raw;
    C_.tid = threadIdx.x; C_.lane = C_.tid & 63; C_.wave = __builtin_amdgcn_readfirstlane(C_.tid >> 6);
    C_.G = gridDim.x; { const int bx = blockIdx.x; C_.vcu = (C_.G % 8 == 0) ? (bx % 8) * (C_.G / 8) + bx / 8 : bx; }
    C_.gw = C_.vcu * 8 + C_.wave; C_.NGW = C_.G * 8; C_.gt = C_.vcu * 512 + C_.tid; C_.NGT = C_.G * 512;
    unsigned char* const ws0 = args.ws;
    unsigned* ctl = (unsigned*)(ws0 + WS_CTL);
    volatile LAS unsigned* lctl = (volatile LAS unsigned*)(C_.lds + LDS_CTL);
    if (C_.tid < 32) lctl[C_.tid] = 0u;
    __syncthreads();
    const int lo = args.ph_lo, hi = args.ph_hi;
    XcdBarrier bar; bar.bar = ctl + CW_BARBASE + args.bar_region * CW_BARSTRIDE; bar.x = 0; bar.st = lctl + 8;
    if (hi - lo > 1) bar = xcd_barrier_post(ctl + CW_BARBASE + args.bar_region * CW_BARSTRIDE, lctl + 8);
#ifndef PH_MASK
#define PH_MASK 0x3ffff
#endif
#define IN(k) (opaque_i(lo) <= (k) && (k) < opaque_i(hi))
#define INP(k) (((PH_MASK >> (16 + (k))) & 1) && IN(k))
#define INL(r) (((PH_MASK >> (r)) & 1) && IN(P + (r)))
#define SEAM(k) do { if (IN(k) && IN((k) + 1)) xcd_barrier(bar); } while (0)
    const int G0 = C_.G, cb0 = (int)blockIdx.x, vcu0 = C_.vcu;
    LAS unsigned char* lds = C_.lds;
#define PHASE_BEGIN unsigned char* ws = opaque_s(ws0); const int G = opaque_i(G0), cb = opaque_i(cb0); Ctx C; C.lds = lds; C.tid = opaque_v((int)threadIdx.x); C.lane = C.tid & 63; C.wave = __builtin_amdgcn_readfirstlane(C.tid >> 6); C.G = G; C.vcu = vcu0; C.gw = vcu0 * 8 + C.wave; C.NGW = G * 8; C.gt = vcu0 * 512 + C.tid; C.NGT = G * 512; (void)ws; (void)C;

    if (INP(0)) { PHASE_BEGIN prologue_a(C, args); }
    SEAM(0);
    if (INP(1)) { PHASE_BEGIN
        prologue_b_tables(C, args);
        KvOrder S{(const char*)(ws + WS_MEMB), (const char*)(ws + WS_WKV), G, cb};
        EpiKv E{(bf16_t*)(ws + WS_KM), (bf16_t*)(ws + WS_VT)};
        pg::gemm_phase<EpiKv, KvOrder, false>(lds, pg::Shape{1024, 1024, 1024}, S, E);
    }
    SEAM(1);

    for (int L = 0; L < NL; ++L) {
        const int P = 2 + L * PH_PER_LAYER, j2 = L >> 1; const bool moe = (L & 1) != 0;
        unsigned* moecnt = ctl + CW_MOECNT + L * 1024;
#define LAYER_PTRS const float* Xres = (L == 0) ? args.in[0] : (const float*)(ws + WS_XF); float* XF = (float*)(ws + WS_XF); bf16_t* XB = (bf16_t*)(ws + WS_XB); float* T = (float*)(ws + WS_T); (void)Xres; (void)XF; (void)XB; (void)T;
        if (INL(0)) { PHASE_BEGIN LAYER_PTRS
            pg::PlainOrder S; S.init(XB, ws + WS_WIN + (size_t)L * SZ_WIN, NTOK, INW, 1024, 1024, G, cb);
            EpiInProj E{(bf16_t*)(ws + WS_Q), (bf16_t*)(ws + WS_KK), (bf16_t*)(ws + WS_VV), (bf16_t*)(ws + WS_U), (bf16_t*)(ws + WS_UP), (bf16_t*)(ws + WS_GT), args.in[3] + (size_t)L * 3072, (const float*)(ws + WS_ROPE)};
            pg::gemm_phase<EpiInProj, pg::PlainOrder, true>(lds, pg::Shape{1024, 1024, 1024}, S, E);
        }
        SEAM(P + 0);
        if (INL(1)) { PHASE_BEGIN LAYER_PTRS
#ifndef SUB_MASK
#define SUB_MASK 7
#endif
            if (SUB_MASK & 1) swa_phase(C, (const bf16_t*)(ws + WS_Q), (const bf16_t*)(ws + WS_KK), (const bf16_t*)(ws + WS_VV), args.in[4] + L * 8, (bf16_t*)(ws + WS_ATTNO));
            if (SUB_MASK & 2) pool_phase(C, (const bf16_t*)(ws + WS_UP), (bf16_t*)(ws + WS_POOLED));
            __syncthreads();
            if (SUB_MASK & 4) {
            SsmEOrder S{(const char*)(ws + WS_U), (const char*)(ws + WS_PT + (size_t)L * SZ_PT), G, cb};
            EpiSsmE E{(bf16_t*)(ws + WS_U), (const float*)(ws + WS_PWR + (size_t)L * SZ_PWR)};
            pg::gemm_phase<EpiSsmE, SsmEOrder, false>(lds, pg::Shape{512, 640, 512}, S, E);
            }
        }
        SEAM(P + 1);
        if (INL(2)) { PHASE_BEGIN LAYER_PTRS
            { SsmYOrder S{(const char*)(ws + WS_U), (const char*)(ws + WS_MT + (size_t)L * SZ_MT), G, cb};
              EpiSsmY E{(bf16_t*)(ws + WS_YG)};
              pg::gemm_phase<EpiSsmY, SsmYOrder, false>(lds, pg::Shape{640, 640, 640}, S, E); }
            { pg::PlainOrder S; S.init(ws + WS_POOLED, ws + WS_WPOOL + (size_t)L * SZ_WPOOL, NTOK, 512, 512, 512, G, cb);
              EpiColScale E{(bf16_t*)(ws + WS_MIXED), 512, args.in[15] + (size_t)L * 512};
              pg::gemm_phase<EpiColScale, pg::PlainOrder, false>(lds, pg::Shape{512, 512, 512}, S, E); }
        }
        SEAM(P + 2);
        if (INL(3)) { PHASE_BEGIN LAYER_PTRS
            pg::PlainOrder S; S.init(ws + WS_YG, ws + WS_WGLU + (size_t)L * SZ_WGLU, NTOK, 1024, 512, 512, G, cb);
            EpiGlu<0> E{(bf16_t*)(ws + WS_SSMH), 512};
            pg::gemm_phase<EpiGlu<0>, pg::PlainOrder, true>(lds, pg::Shape{512, 512, 512}, S, E);
        }
        SEAM(P + 3);
        if (INL(4)) { PHASE_BEGIN LAYER_PTRS
            const bf16_t* GT = (const bf16_t*)(ws + WS_GT); bf16_t* MG = (bf16_t*)(ws + WS_MERGED);
            const unsigned char* wbr = ws + WS_WBR + (size_t)L * 3 * SZ_WBR;
            { pg::PlainOrder S; S.init(ws + WS_ATTNO, wbr, NTOK, 1024, 512, 512, G, cb); EpiBranch<false> E{GT, MG, 0};
              pg::gemm_phase<EpiBranch<false>, pg::PlainOrder, true>(lds, pg::Shape{512, 512, 512}, S, E); }
            asm volatile("s_waitcnt vmcnt(0)" ::: "memory"); __syncthreads(); __builtin_amdgcn_fence(__ATOMIC_ACQUIRE, "agent"); asm volatile("s_waitcnt vmcnt(0)" ::: "memory"); __syncthreads();
            { pg::PlainOrder S; S.init(ws + WS_SSMH, wbr + SZ_WBR, NTOK, 1024, 512, 512, G, cb); EpiBranch<true> E{GT, MG, 1};
              pg::gemm_phase<EpiBranch<true>, pg::PlainOrder, true>(lds, pg::Shape{512, 512, 512}, S, E); }
            asm volatile("s_waitcnt vmcnt(0)" ::: "memory"); __syncthreads(); __builtin_amdgcn_fence(__ATOMIC_ACQUIRE, "agent"); asm volatile("s_waitcnt vmcnt(0)" ::: "memory"); __syncthreads();
            { pg::PlainOrder S; S.init(ws + WS_MIXED, wbr + 2 * SZ_WBR, NTOK, 1024, 512, 512, G, cb); EpiBranch<true> E{GT, MG, 2};
              pg::gemm_phase<EpiBranch<true>, pg::PlainOrder, true>(lds, pg::Shape{512, 512, 512}, S, E); }
        }
        SEAM(P + 4);
        if (INL(5)) { PHASE_BEGIN LAYER_PTRS
            pg::PlainOrder S; S.init(ws + WS_MERGED, ws + WS_WO + (size_t)L * SZ_WSQ, NTOK, 1024, 1024, 1024, G, cb);
            EpiResid E{Xres, T};
            pg::gemm_phase<EpiResid, pg::PlainOrder, true>(lds, pg::Shape{1024, 1024, 1024}, S, E);
        }
        SEAM(P + 5);
        if (INL(6)) { PHASE_BEGIN LAYER_PTRS ln_phase<0, false>(C, T, nullptr, args.in[20] + L * 1024, args.in[21] + L * 1024, XF, XB, nullptr, nullptr, nullptr, nullptr, nullptr, nullptr, nullptr, nullptr, nullptr, nullptr, nullptr, nullptr); }
        SEAM(P + 6);
        if (INL(7)) { PHASE_BEGIN LAYER_PTRS
            pg::PlainOrder S; S.init(XB, ws + WS_WQ + (size_t)L * SZ_WSQ, NTOK, 1024, 1024, 1024, G, cb);
            EpiBf16 E{(bf16_t*)(ws + WS_XQ), 1024, XQSCALE};
            pg::gemm_phase<EpiBf16, pg::PlainOrder, true>(lds, pg::Shape{1024, 1024, 1024}, S, E);
        }
        SEAM(P + 7);
        if (INL(8)) { PHASE_BEGIN LAYER_PTRS
            XsOrder S{(const char*)(ws + WS_XQ), (const char*)(ws + WS_KM + (size_t)L * SZ_KM), G, cb};
            EpiSexp E{(bf16_t*)(ws + WS_PB), (float*)(ws + WS_RS)};
            pg::gemm_phase<EpiSexp, XsOrder, true>(lds, pg::Shape{256, 1024, 1024}, S, E);
        }
        SEAM(P + 8);
        if (INL(9)) { PHASE_BEGIN LAYER_PTRS
            XpvOrder S{(const char*)(ws + WS_PB), (const char*)(ws + WS_VT + (size_t)L * SZ_VT), G, cb};
            EpiPv E{(bf16_t*)(ws + WS_XO), (const float*)(ws + WS_RS)};
            pg::gemm_phase<EpiPv, XpvOrder, true>(lds, pg::Shape{256, 1024, 256}, S, E);
        }
        SEAM(P + 9);
        if (INL(10)) { PHASE_BEGIN LAYER_PTRS
            pg::PlainOrder S; S.init(ws + WS_XO, ws + WS_WXO + (size_t)L * SZ_WSQ, NTOK, 1024, 1024, 1024, G, cb);
            EpiResid E{XF, T};
            pg::gemm_phase<EpiResid, pg::PlainOrder, true>(lds, pg::Shape{1024, 1024, 1024}, S, E);
        }
        SEAM(P + 10);
        if (INL(11)) { PHASE_BEGIN LAYER_PTRS
            if (!moe) ln_phase<0, false>(C, T, nullptr, args.in[25] + L * 1024, args.in[26] + L * 1024, XF, XB, nullptr, nullptr, nullptr, nullptr, nullptr, nullptr, nullptr, nullptr, nullptr, nullptr, nullptr, nullptr);
            else ln_phase<0, true>(C, T, nullptr, args.in[25] + L * 1024, args.in[26] + L * 1024, XF, XB, nullptr, nullptr, nullptr, nullptr,
                                   args.in[29] + (size_t)j2 * 8192, args.in[30] + j2 * 8, (int*)(ws + WS_RTE), (int*)(ws + WS_RTP), (float*)(ws + WS_RTW), (int*)(ws + WS_SRC), (float*)(ws + WS_WL), moecnt);
        }
        SEAM(P + 11);
        if (INL(12)) { PHASE_BEGIN LAYER_PTRS if (moe) moe_gather_phase(C, moecnt, (const int*)(ws + WS_SRC), (const float*)(ws + WS_WL), XB, (bf16_t*)(ws + WS_XG), (float*)(ws + WS_WSLOT)); }
        SEAM(P + 12);
        if (INL(13)) { PHASE_BEGIN LAYER_PTRS
            if (!moe) { pg::PlainOrder S; S.init(XB, ws + WS_WGU + (size_t)j2 * SZ_WGU, NTOK, 2 * DFF, 1024, 1024, G, cb);
                EpiGlu<1> E{(bf16_t*)(ws + WS_H), DFF};
                pg::gemm_phase<EpiGlu<1>, pg::PlainOrder, true>(lds, pg::Shape{1024, 1024, 1024}, S, E); }
            else { MoeOrder S; S.init(ws + WS_XG, ws + WS_MGU + (size_t)j2 * NE * SZ_MGU, 1024, 1024, 2 * DFFE, SZ_MGU, moecnt, G, cb);
                EpiGlu<1> E{(bf16_t*)(ws + WS_H), DFFE};
                pg::gemm_phase<EpiGlu<1>, MoeOrder, true>(lds, pg::Shape{1024, 1024, 1024}, S, E); }
        }
        SEAM(P + 13);
        if (INL(14)) { PHASE_BEGIN LAYER_PTRS
            if (!moe) { pg::PlainOrder S; S.init(ws + WS_H, ws + WS_WDN + (size_t)j2 * SZ_WDN, NTOK, 1024, DFF, DFF, G, cb);
                EpiResid E{XF, T};
                pg::gemm_phase<EpiResid, pg::PlainOrder, true>(lds, pg::Shape{DFF, DFF, DFF}, S, E); }
            else { MoeOrder S; S.init(ws + WS_H, ws + WS_MDN + (size_t)j2 * NE * SZ_MDN, DFFE, DFFE, 1024, SZ_MDN, moecnt, G, cb);
                EpiMoeDown E{(bf16_t*)(ws + WS_XG), (const float*)(ws + WS_WSLOT)};
                pg::gemm_phase<EpiMoeDown, MoeOrder, true>(lds, pg::Shape{DFFE, DFFE, DFFE}, S, E); }
        }
        SEAM(P + 14);
        if (INL(15)) { PHASE_BEGIN LAYER_PTRS
            float* xo = (L == NL - 1) ? args.out : XF;
            if (!moe) ln_phase<0, false>(C, T, nullptr, args.in[33] + L * 1024, args.in[34] + L * 1024, xo, XB, nullptr, nullptr, nullptr, nullptr, nullptr, nullptr, nullptr, nullptr, nullptr, nullptr, nullptr, nullptr);
            else ln_phase<1, false>(C, nullptr, XF, args.in[33] + L * 1024, args.in[34] + L * 1024, xo, XB, (const bf16_t*)(ws + WS_XG), (const int*)(ws + WS_RTE), (const int*)(ws + WS_RTP), moecnt, nullptr, nullptr, nullptr, nullptr, nullptr, nullptr, nullptr, nullptr);
        }
        SEAM(P + 15);
    }
#undef IN
#undef PHASE_BEGIN
#undef LAYER_PTRS
#undef INP
#undef INL
#undef SEAM
}
}
#ifndef BUILD_MODE
#define BUILD_MODE 0
#endif
#ifndef DBG_BASE
#define DBG_BASE 0
#endif
#if BUILD_MODE == 2
namespace dbg {
constexpr int DBG_R = 4096;
struct CmpP { const float* ref; const void* test; const float* bias; float* err; int rows, cols, ldr, rcoff, ldt, tcoff, mode, id, refop, pad; float rscale; int pad2; };
__global__ void cmp_k(CmpP p) {
    float num = 0.f, den = 0.f; const long long n = (long long)p.rows * p.cols;
    for (long long idx = (long long)blockIdx.x * blockDim.x + threadIdx.x; idx < n; idx += (long long)gridDim.x * blockDim.x) {
        const int row = (int)(idx / p.cols), c = (int)(idx % p.cols);
        float r = p.ref[(size_t)row * p.ldr + p.rcoff + c];
        r = p.refop == 1 ? 1.f / (1.f + expf(-(r + p.bias[c]))) : r * p.rscale;
        float t;
        if (p.mode == 0) t = bf2f(((const bf16_t*)p.test)[(size_t)row * p.ldt + p.tcoff + c]);
        else if (p.mode == 1) t = ((const float*)p.test)[(size_t)row * p.ldt + p.tcoff + c];
        else t = bf2f(((const bf16_t*)p.test)[(size_t)(c >> 4) * fp::UG_STRIDE + (size_t)(row >> 5) * 640 + (row & 31) * 16 + (c & 15)]);
        const float d = r - t; num += d * d; den += r * r;
        if (!(t - t == 0.f)) num += 1.0e30f;
    }
    num = wave_sum(num); den = wave_sum(den);
    if ((threadIdx.x & 63) == 0) { atomicAdd(p.err + 2 * p.id, num); atomicAdd(p.err + 2 * p.id + 1, den); }
}
__global__ void cmp_route_k(const int* tope_ref, const int* rte, float* err, int id, int R) {
    float bad = 0.f;
    for (int row = blockIdx.x * blockDim.x + threadIdx.x; row < R; row += gridDim.x * blockDim.x) bad += (tope_ref[row * 2] != rte[row * 2] || tope_ref[row * 2 + 1] != rte[row * 2 + 1]) ? 1.f : 0.f;
    bad = wave_sum(bad);
    if ((threadIdx.x & 63) == 0) atomicAdd(err + 2 * id, bad);
    if (blockIdx.x == 0 && threadIdx.x == 0) atomicAdd(err + 2 * id + 1, (float)R * 20.f);
}
__global__ void decide_k(const float* err, int nchecks, float tol, int base, int* code) {
    if (threadIdx.x == 0 && blockIdx.x == 0) { int c = 0;
        for (int i = 0; i < nchecks; ++i) { const float num = err[2 * i], den = err[2 * i + 1]; const bool bad = !(num <= tol * den) || !(den > 0.f); if (bad) { c = i - base + 1; if (c < 1) c = 1; if (c > 28) c = 28; break; } }
        *code = c; }
}
__global__ void sign_k(float* out, const float* xn, const int* code, int R) {
    const float k = 1.f + (float)(*code);
    for (long long i = (long long)blockIdx.x * blockDim.x + threadIdx.x; i < (long long)fp::NTOK * 1024; i += (long long)gridDim.x * blockDim.x) out[i] = i < (long long)R * 1024 ? xn[i] * k : 0.f;
}
}
#endif

extern "C" void kernel_launch(void* const* d_in, const int* in_sizes, int n_in, void* d_out, int out_size, void* d_ws, size_t ws_size, hipStream_t stream) {
    (void)in_sizes; (void)n_in; (void)out_size;
    static int grid = 0;
    if (grid == 0) {
        int dev = 0, cus = 0;
        if (hipGetDevice(&dev) != hipSuccess || hipDeviceGetAttribute(&cus, hipDeviceAttributeMultiprocessorCount, dev) != hipSuccess) { fprintf(stderr, "kernel_launch: device query failed\n"); grid = -1; return; }
        if (hipFuncSetAttribute((const void*)fp::fwd, hipFuncAttributeMaxDynamicSharedMemorySize, fp::LDS_BYTES) != hipSuccess) { fprintf(stderr, "kernel_launch: hipFuncSetAttribute failed\n"); grid = -1; return; }
        int per_cu = 0; (void)hipOccupancyMaxActiveBlocksPerMultiprocessor(&per_cu, (const void*)fp::fwd, 512, fp::LDS_BYTES); (void)hipGetLastError();
        grid = cus;
        if (ws_size < fp::WS_FAST_END2) { fprintf(stderr, "kernel_launch: workspace too small (%zu < %zu)\n", ws_size, (size_t)fp::WS_FAST_END2); grid = -1; return; }
    }
    if (grid < 0) return;
    (void)hipMemsetAsync((char*)d_ws + fp::WS_CTL, 0, fp::CTL_BYTES, stream);
    fp::Args a; memset(&a, 0, sizeof(a));
    for (int i = 0; i < 35; ++i) a.in[i] = (const float*)d_in[i];
    a.out = (float*)d_out; a.ws = (unsigned char*)d_ws;
    auto run = [&](int lo, int hi, int region) { a.ph_lo = lo; a.ph_hi = hi; a.bar_region = region; hipLaunchKernelGGL(fp::fwd, dim3(grid), dim3(512), fp::LDS_BYTES, stream, a); };
#if BUILD_MODE == 0
    run(0, fp::N_PHASES, 0);
#elif BUILD_MODE == 1
    for (int p = 0; p < fp::N_PHASES; ++p) run(p, p + 1, 0);
#else
    using namespace dbg;
    unsigned char* ws = (unsigned char*)d_ws;
    float* err = (float*)(ws + fp::WS_CTL) + fp::CW_ERR; int* code = (int*)(err + 512);
    nv::Naive N; N.st = stream; N.in = d_in; N.carve(ws + fp::WS_FAST_END2, DBG_R, 1);
    int nchk = 0;
    auto cmp = [&](const float* ref, int ldr, int rcoff, float rscale, const void* test, int ldt, int tcoff, int mode, int cols, int refop = 0, const float* bias = nullptr) {
        CmpP p; memset(&p, 0, sizeof(p)); p.ref = ref; p.test = test; p.bias = bias; p.err = err; p.rows = DBG_R; p.cols = cols; p.ldr = ldr; p.rcoff = rcoff; p.ldt = ldt; p.tcoff = tcoff; p.mode = mode; p.id = nchk++; p.refop = refop; p.rscale = rscale;
        hipLaunchKernelGGL(cmp_k, dim3(512), dim3(256), 0, stream, p); };
    run(0, 1, 0); run(1, 2, 0);
    const float* Xn = (const float*)d_in[0]; float* nb[2] = {N.XA, N.XB}; int cur = 0;
    for (int L = 0; L < 4; ++L) {
        const int P = 2 + L * fp::PH_PER_LAYER;
        N.mixer_proj(L, Xn); run(P, P + 1, 0);
        cmp(N.PROJ, nv::INW, 0, fp::QSCALE, ws + fp::WS_Q, 512, 0, 0, 512);
        cmp(N.PROJ, nv::INW, 512, 1.f, ws + fp::WS_KK, 128, 0, 0, 128);
        cmp(N.PROJ, nv::INW, 640, 1.f, ws + fp::WS_VV, 128, 0, 0, 128);
        cmp(N.PROJ, nv::INW, 768, 1.f, ws + fp::WS_U, 0, 0, 2, 512);
        cmp(N.PROJ, nv::INW, 1280, 1.f, ws + fp::WS_UP, 512, 0, 0, 512);
        cmp(N.PROJ, nv::INW, 1792, 1.f, ws + fp::WS_GT, 3072, 0, 0, 3072, 1, (const float*)d_in[3] + (size_t)L * 3072);
        N.mixer_attn(L); N.mixer_ssm(L); N.mixer_pool(L); run(P + 1, P + 2, 0); run(P + 2, P + 3, 0); run(P + 3, P + 4, 0);
        cmp(N.ATTNO, 512, 0, 1.f, ws + fp::WS_ATTNO, 512, 0, 0, 512);
        cmp(N.POOLED, 512, 0, 1.f, ws + fp::WS_POOLED, 512, 0, 0, 512);
        cmp(N.YG, 512, 0, 1.f, ws + fp::WS_YG, 512, 0, 0, 512);
        cmp(N.MIXED, 512, 0, 1.f, ws + fp::WS_MIXED, 512, 0, 0, 512);
        cmp(N.SSMH, 512, 0, 1.f, ws + fp::WS_SSMH, 512, 0, 0, 512);
        N.mixer_merge(L); run(P + 4, P + 5, 0);
        cmp(N.MERGED, 1024, 0, 1.f, ws + fp::WS_MERGED, 1024, 0, 0, 1024);
        float* X1 = nb[cur]; cur ^= 1; N.mixer_out(L, Xn, X1); run(P + 5, P + 6, 0); run(P + 6, P + 7, 0);
        cmp(X1, 1024, 0, 1.f, ws + fp::WS_XF, 1024, 0, 1, 1024);
        N.xattn_qkv(L, X1); run(P + 7, P + 8, 0);
        cmp(N.Q, 1024, 0, fp::XQSCALE, ws + fp::WS_XQ, 1024, 0, 0, 1024);
        N.xattn_core(); run(P + 8, P + 9, 0); run(P + 9, P + 10, 0);
        cmp(N.XO, 1024, 0, 1.f, ws + fp::WS_XO, 1024, 0, 0, 1024);
        float* X2 = nb[cur]; cur ^= 1; N.xattn_out(L, X1, X2); run(P + 10, P + 11, 0); run(P + 11, P + 12, 0);
        cmp(X2, 1024, 0, 1.f, ws + fp::WS_XF, 1024, 0, 1, 1024);
        float* X3 = nb[cur]; cur ^= 1;
        if ((L & 1) == 0) { N.ffn_dense(L, X2, X3); run(P + 12, P + 13, 0); run(P + 13, P + 14, 0);
            cmp(N.H, fp::DFF, 0, 1.f, ws + fp::WS_H, fp::DFF, 0, 0, fp::DFF);
        } else { N.ffn_moe_route(L, X2); N.ffn_moe(L, X2, X3); run(P + 12, P + 13, 0); run(P + 13, P + 14, 0);
            hipLaunchKernelGGL(cmp_route_k, dim3(64), dim3(256), 0, stream, (const int*)N.tope, (const int*)(ws + fp::WS_RTE), err, nchk++, DBG_R); }
        run(P + 14, P + 15, 0); run(P + 15, P + 16, 0);
        cmp(X3, 1024, 0, 1.f, (L == 3) ? (const void*)d_out : (const void*)(ws + fp::WS_XF), 1024, 0, 1, 1024);
        Xn = X3;
    }
    hipLaunchKernelGGL(decide_k, dim3(1), dim3(64), 0, stream, (const float*)err, nchk, 2.0e-3f, (int)DBG_BASE, code);
    hipLaunchKernelGGL(sign_k, dim3(2048), dim3(256), 0, stream, (float*)d_out, Xn, (const int*)code, DBG_R);
#endif
}
```

```cpp
#define BUILD_MODE 0
#define DBG_BASE 0
#include <hip/hip_runtime.h>
#include <cstdio>
#include <cstdint>
#include <cstring>
#define LAS __attribute__((address_space(3)))
#define GAS __attribute__((address_space(1)))
#define DI __device__ __forceinline__
typedef unsigned short bf16_t;
typedef short bf16x8 __attribute__((ext_vector_type(8)));
typedef short s16x4 __attribute__((ext_vector_type(4)));
typedef float f32x4 __attribute__((ext_vector_type(4)));
typedef float f32x2 __attribute__((ext_vector_type(2)));
typedef float f32x16 __attribute__((ext_vector_type(16)));
typedef unsigned u32x4 __attribute__((ext_vector_type(4)));
typedef unsigned u32x2 __attribute__((ext_vector_type(2)));
typedef __bf16 bf16x2_t __attribute__((ext_vector_type(2)));
typedef GAS unsigned gu32;
#define RLX_AGENT __ATOMIC_RELAXED, __HIP_MEMORY_SCOPE_AGENT

DI unsigned pk2(float lo, float hi) { f32x2 v = {lo, hi}; bf16x2_t b = __builtin_convertvector(v, bf16x2_t); return __builtin_bit_cast(unsigned, b); }
DI float bf2f(unsigned short b) { return __uint_as_float(((unsigned)b) << 16); }
DI float bflo(unsigned w) { return __uint_as_float(w << 16); }
DI float bfhi(unsigned w) { return __uint_as_float(w & 0xffff0000u); }
DI int opaque_v(int x) { asm volatile("" : "+v"(x)); return x; }
DI int opaque_i(int x) { asm volatile("" : "+s"(x)); return x; }
template <class T> DI T* opaque_s(T* p) { asm volatile("" : "+s"(p)); return p; }
DI float wave_sum(float v) {
#pragma unroll
    for (int o = 1; o < 64; o <<= 1) v += __shfl_xor(v, o);
    return v;
}
DI float fast_exp2(float x) { return __builtin_amdgcn_exp2f(x); }
DI float fast_rcp(float x) { return __builtin_amdgcn_rcpf(x); }
DI float sigmoid_f(float x) { return fast_rcp(1.f + fast_exp2(-1.4426950408889634f * x)); }
DI float silu_f(float x) { return x * sigmoid_f(x); }
DI float gelu_tanh_f(float x) { const float u = 0.7978845608028654f * (x + 0.044715f * x * x * x); return x * sigmoid_f(2.f * u); }

#define XB_TMO      128
#define XB_XCNT(j)  (256  + 64 * (j))
#define XB_XSUB(j)  (1280 + 64 * (j))
#define XB_XGEN(j)  (2304 + 64 * (j))
#define XB_TOP      3328
#define XB_TOPGEN   3392
#define XCD_BAR_WORDS 3456
#define XB_SPIN_CAP (1u << 22)
DI unsigned xb_ld(unsigned* p)              { return __hip_atomic_load(p, __ATOMIC_RELAXED, __HIP_MEMORY_SCOPE_AGENT); }
DI unsigned xb_add(unsigned* p, unsigned v) { return __hip_atomic_fetch_add(p, v, __ATOMIC_RELAXED, __HIP_MEMORY_SCOPE_AGENT); }
DI unsigned xb_xcc_id() { return (unsigned)__builtin_amdgcn_s_getreg((3 << 11) | 20) & 0xFu; }
#define XB_SPIN(cond, bar) do { unsigned _sp = 0; while (cond) { __builtin_amdgcn_s_sleep(1); \
    if ((++_sp & 255u) == 0u) { if (xb_ld(&(bar)[XB_TMO])) break; if (_sp > XB_SPIN_CAP) { atomicAdd(&(bar)[XB_TMO], 1u); break; } } } } while (0)
struct XcdBarrier { unsigned* bar; unsigned x; volatile LAS unsigned* st; };
DI XcdBarrier xcd_barrier_post(unsigned* bar, volatile LAS unsigned* st) {
    XcdBarrier b; b.bar = bar; b.x = xb_xcc_id(); b.st = st;
    if (threadIdx.x == 0) (void)xb_add(&bar[XB_XCNT(b.x)], 1u);
    return b;
}
DI void xcd_barrier_complete(unsigned* bar, unsigned x, unsigned& nloc, unsigned& nx) {
    const unsigned G = gridDim.x * gridDim.y * gridDim.z;
    unsigned sum, cnt, mine, sp = 0u;
    for (;;) {
        sum = 0u; cnt = 0u; mine = 0u;
#pragma unroll
        for (unsigned j = 0; j < 16; ++j) { const unsigned c = xb_ld(&bar[XB_XCNT(j)]); sum += c; cnt += (c > 0u) ? 1u : 0u; mine = (j == x) ? c : mine; }
        if (sum == G) break;
        __builtin_amdgcn_s_sleep(1);
        if ((++sp & 255u) == 0u) { if (xb_ld(&bar[XB_TMO])) break; if (sp > XB_SPIN_CAP) { atomicAdd(&bar[XB_TMO], 1u); break; } }
    }
    nloc = mine > 0u ? mine : 1u; nx = cnt > 0u ? cnt : 1u;
}
DI void xcd_barrier(const XcdBarrier& b) {
    asm volatile("s_waitcnt vmcnt(0)" ::: "memory");
    __syncthreads();
    if (threadIdx.x == 0) {
        unsigned* bar = b.bar;
        __builtin_amdgcn_s_waitcnt(0);
        unsigned nloc = b.st[0], nx = b.st[1];
        if (nloc == 0u) { xcd_barrier_complete(bar, b.x, nloc, nx); b.st[0] = nloc; b.st[1] = nx; }
        const unsigned old = xb_add(&bar[XB_XSUB(b.x)], 1u);
        const unsigned gen = old / nloc;
        if (old + 1u == (gen + 1u) * nloc) {
            __builtin_amdgcn_fence(__ATOMIC_RELEASE, "agent");
            asm volatile("s_waitcnt vmcnt(0)" ::: "memory");
            const unsigned og = xb_add(&bar[XB_TOP], 1u);
            const unsigned tg = og / nx;
            if (og + 1u == (tg + 1u) * nx) xb_add(&bar[XB_TOPGEN], 1u);
            else XB_SPIN(xb_ld(&bar[XB_TOPGEN]) == tg, bar);
            __builtin_amdgcn_fence(__ATOMIC_ACQUIRE, "agent");
            xb_add(&bar[XB_XGEN(b.x)], 1u);
            asm volatile("s_waitcnt vmcnt(0)" ::: "memory");
        } else {
            XB_SPIN(xb_ld(&bar[XB_XGEN(b.x)]) == gen, bar);
            __builtin_amdgcn_fence(__ATOMIC_ACQUIRE, "agent");
            asm volatile("s_waitcnt vmcnt(0)" ::: "memory");
        }
    }
    __syncthreads();
}

namespace pg {
constexpr int BM = 256, BK = 64, HALF = 128, HTB = HALF * BK * 2, STAGE_BYTES = 8 * HTB, NXCD = 8, WGM = 8;
__host__ __device__ __forceinline__ int lds_byte(int r, int c) { const int st = (r >> 4) * 2 + (c >> 5), rr = r & 15, cc = c & 31, ob = rr * 64 + cc * 2; return st * 1024 + (ob ^ (((ob >> 9) & 1) << 5)); }
__host__ __device__ __forceinline__ void stage_rc(int b, int& R, int& C) { const int st = b / 1024, sb = b % 1024, swz = sb ^ (((sb >> 9) & 1) << 5); R = (st >> 1) * 16 + swz / 64; C = (st & 1) * 32 + (swz % 64) / 2; }
__host__ __device__ __forceinline__ int perm32(int rho) { const int n = rho >> 4, i = rho & 15; return 8 * (i >> 2) + 4 * n + (i & 3); }

struct Unit { int pm, pn, z, row0, col0; const char* a; const char* b; };
struct Shape { int K, lda, ldb; };

DI bool tile_of(int i, int G, int c, int nM, int nN, int& pm, int& pn) {
    const int nwg = nM * nN; const long L = (long)i * G + c; if (L >= nwg) return false;
    int wgid = (int)L; { const int q = nwg / NXCD, r = nwg % NXCD, xcd = wgid % NXCD, off = wgid / NXCD; wgid = (xcd < r ? xcd * (q + 1) : r * (q + 1) + (xcd - r) * q) + off; }
    const int nig = WGM * nN, gid = wgid / nig, fm = gid * WGM, gsz = (nM - fm) < WGM ? (nM - fm) : WGM;
    pm = fm + ((wgid % nig) % gsz); pn = (wgid % nig) / gsz; return true;
}
struct PlainOrder {
    const char* A; const char* Bt; int nM, nN, G, c; size_t astep, bstep;
    DI void init(const void* A_, const void* Bt_, int M, int N, int lda, int ldb, int G_, int c_) { A = (const char*)A_; Bt = (const char*)Bt_; nM = M / BM; nN = N / BM; G = G_; c = c_; astep = (size_t)BM * lda * 2; bstep = (size_t)BM * ldb * 2; }
    DI bool next(int i, Unit& u) const { if (!tile_of(i, G, c, nM, nN, u.pm, u.pn)) return false; u.z = 0; u.row0 = u.pm * BM; u.col0 = u.pn * BM; u.a = A + (size_t)u.pm * astep; u.b = Bt + (size_t)u.pn * bstep; return true; }
};

template <class Epi, class Sched, bool ALIGN_EPI>
DI void gemm_phase(LAS unsigned char* lds, const Shape g, const Sched& S, const Epi& E) {
    const int tid = opaque_v((int)threadIdx.x), wid = __builtin_amdgcn_readfirstlane(tid >> 6), lane = tid & 63, wr = wid >> 2, wc = wid & 3, fr = lane & 15, fq = lane >> 4;
    const int nt = g.K / BK;
    unsigned voffA[2], voffB[2];
#pragma unroll
    for (int i = 0; i < 2; ++i) { int R, C; stage_rc(tid * 16 + i * 8192, R, C); const int Rb = Epi::PERM ? ((R & ~31) + perm32(R & 31)) : R;
        voffA[i] = (unsigned)(R * g.lda + C) * 2u; voffB[i] = (unsigned)(Rb * g.ldb + C) * 2u; }
    const size_t kstep = (size_t)(BK * 2);
    const size_t hstepA = (size_t)HALF * g.lda * 2, hstepB = (size_t)HALF * g.ldb * 2;
    const unsigned ldsw = (unsigned)wid * 1024u;
    const int aoff = lds_byte(wr * 64 + fr, fq * 8), boff = lds_byte(wc * 32 + fr, fq * 8);
#define PG8_SA(b, h) (((b) * 2 + (h)) * HTB)
#define PG8_SB(b, h) ((4 + (b) * 2 + (h)) * HTB)
#define PG8_STAGE(bufoff, gbase, voff) do { _Pragma("unroll") for (int _i = 0; _i < 2; ++_i) { unsigned _vo = (voff)[_i]; asm volatile("" : "+v"(_vo)); \
        __builtin_amdgcn_global_load_lds((const unsigned*)((const char*)(gbase) + _vo), (LAS unsigned*)(lds + (bufoff) + ldsw + _i * 8192), 16, 0, 0); } } while (0)
#define PG8_LDA(dst, b, h) do { _Pragma("unroll") for (int m = 0; m < 4; ++m) _Pragma("unroll") for (int k = 0; k < 2; ++k) dst[m][k] = *(const LAS bf16x8*)(lds + PG8_SA(b, h) + aoff + m * 2048 + k * 1024); } while (0)
#define PG8_LDB(dst, b, h) do { _Pragma("unroll") for (int n = 0; n < 2; ++n) _Pragma("unroll") for (int k = 0; k < 2; ++k) dst[n][k] = *(const LAS bf16x8*)(lds + PG8_SB(b, h) + boff + n * 2048 + k * 1024); } while (0)
#define PG8_MMA(ai, bj, At, Bt) do { __builtin_amdgcn_s_setprio(1); _Pragma("unroll") for (int m = 0; m < 4; ++m) _Pragma("unroll") for (int n = 0; n < 2; ++n) _Pragma("unroll") for (int k = 0; k < 2; ++k) \
        acc[ai][bj][m][n] = __builtin_amdgcn_mfma_f32_16x16x32_bf16(Bt[n][k], At[m][k], acc[ai][bj][m][n], 0, 0, 0); __builtin_amdgcn_s_setprio(0); } while (0)
#define PG8_WAIT_V(n) asm volatile("s_waitcnt vmcnt(" #n ")" ::: "memory")
#define PG8_WAIT_L(n) asm volatile("s_waitcnt lgkmcnt(" #n ")" ::: "memory")
#define PG8_BAR __builtin_amdgcn_s_barrier()
#define PG8_SCHED __builtin_amdgcn_sched_barrier(0)
    Unit cur, nxt; int ui = 0;
    if (!S.next(0, cur)) return;
    f32x4 acc[2][2][4][2];
#pragma unroll
    for (int a = 0; a < 2; ++a)
#pragma unroll
        for (int b = 0; b < 2; ++b)
#pragma unroll
            for (int m = 0; m < 4; ++m)
#pragma unroll
                for (int n = 0; n < 2; ++n) acc[a][b][m][n] = (f32x4){0.f, 0.f, 0.f, 0.f};
    bf16x8 At[4][2], B0[2][2], B1[2][2];
    const char* cA = cur.a; const char* cB = cur.b;
    PG8_STAGE(PG8_SB(0, 0), cB, voffB); PG8_STAGE(PG8_SB(0, 1), cB + hstepB, voffB); PG8_STAGE(PG8_SA(0, 0), cA, voffA); PG8_STAGE(PG8_SA(0, 1), cA + hstepA, voffA);
    if (wr == 1) PG8_BAR;
    PG8_WAIT_V(2); PG8_BAR;
    PG8_STAGE(PG8_SB(1, 0), cB + kstep, voffB); PG8_STAGE(PG8_SA(1, 0), cA + kstep, voffA); PG8_STAGE(PG8_SB(1, 1), cB + hstepB + kstep, voffB);
    PG8_WAIT_V(6); PG8_BAR;
    for (;;) {
        const bool has_next = S.next(ui + 1, nxt);
        const char* nA = has_next ? nxt.a : cA; const char* nB = has_next ? nxt.b : cB;
        for (int t = 0; t < nt; t += 2) {
            const bool last = (t == nt - 2);
            const char* a1 = cA + (size_t)(t + 1) * kstep;
            const char* a2 = last ? nA : cA + (size_t)(t + 2) * kstep; const char* b2 = last ? nB : cB + (size_t)(t + 2) * kstep;
            const char* a3 = a2 + kstep; const char* b3 = b2 + kstep;
            PG8_LDB(B0, 0, 0); PG8_LDB(B1, 0, 1); PG8_SCHED; PG8_LDA(At, 0, 0); PG8_STAGE(PG8_SA(1, 1), a1 + hstepA, voffA);
            PG8_WAIT_V(8); PG8_WAIT_L(0); PG8_BAR; PG8_MMA(0, 0, At, B0); PG8_MMA(0, 1, At, B1); PG8_BAR; PG8_SCHED;
            PG8_LDA(At, 0, 1); PG8_STAGE(PG8_SB(0, 0), b2, voffB); PG8_STAGE(PG8_SB(0, 1), b2 + hstepB, voffB); PG8_STAGE(PG8_SA(0, 0), a2, voffA);
            PG8_WAIT_V(8); PG8_WAIT_L(0); PG8_BAR; PG8_MMA(1, 0, At, B0); PG8_MMA(1, 1, At, B1); PG8_BAR; PG8_SCHED;
            PG8_LDB(B0, 1, 0); PG8_LDB(B1, 1, 1); PG8_SCHED; PG8_LDA(At, 1, 0); PG8_STAGE(PG8_SA(0, 1), a2 + hstepA, voffA);
            PG8_WAIT_V(8); PG8_WAIT_L(0); PG8_BAR; PG8_MMA(0, 0, At, B0); PG8_MMA(0, 1, At, B1); PG8_BAR; PG8_SCHED;
            PG8_LDA(At, 1, 1); PG8_STAGE(PG8_SB(1, 0), b3, voffB); PG8_STAGE(PG8_SB(1, 1), b3 + hstepB, voffB); PG8_STAGE(PG8_SA(1, 0), a3, voffA);
            PG8_WAIT_V(8); PG8_WAIT_L(0); PG8_BAR; PG8_MMA(1, 0, At, B0); PG8_MMA(1, 1, At, B1); PG8_BAR; PG8_SCHED;
        }
        if constexpr (ALIGN_EPI) { if (wr == 0) PG8_BAR; }
        if constexpr (!Epi::AFTER_DRAIN) { E(acc, cur, wr, wc, fr, fq); }
        if (!has_next) break;
#pragma unroll
        for (int a = 0; a < 2; ++a)
#pragma unroll
            for (int b = 0; b < 2; ++b)
#pragma unroll
                for (int m = 0; m < 4; ++m)
#pragma unroll
                    for (int n = 0; n < 2; ++n) acc[a][b][m][n] = (f32x4){0.f, 0.f, 0.f, 0.f};
        cur = nxt; cA = nA; cB = nB; ++ui;
        if constexpr (ALIGN_EPI) { if (wr == 1) PG8_BAR; }
    }
    PG8_WAIT_V(0);
    if constexpr (!ALIGN_EPI) { if (wr == 0) PG8_BAR; }
    PG8_BAR;
    if constexpr (Epi::AFTER_DRAIN) { E.fused(acc, cur, wr, wc, fr, fq, lds, wid, lane); }
#undef PG8_SA
#undef PG8_SB
#undef PG8_STAGE
#undef PG8_LDA
#undef PG8_LDB
#undef PG8_MMA
#undef PG8_WAIT_V
#undef PG8_WAIT_L
#undef PG8_BAR
#undef PG8_SCHED
}
}
namespace fp {
constexpr int NTOK = 32768, SEQ = 4096, DM = 1024, INW = 4864, NL = 4, DFF = 2816, DFFE = 3584, NE = 8;
constexpr float ALPHA = 1.681792830507429f, LN_EPS = 1e-5f, LOG2E = 1.4426950408889634f;
constexpr float QSCALE = 0.125f * LOG2E, XQSCALE = 0.0625f * LOG2E;
constexpr int UG_STRIDE = 1024 * 640;
constexpr int MOE_ROWS = 65536 + 8 * 256;

constexpr size_t MiB = 1u << 20;
constexpr size_t al(size_t x) { return (x + 255) & ~(size_t)255; }
constexpr size_t WS_CTL = 0, CTL_BYTES = 1 * MiB;
constexpr int CW_BAR = 1024;
constexpr int CW_MOECNT = 8192;
constexpr int CW_ERR = 16384;
constexpr size_t WS_WIN = CTL_BYTES;                                       constexpr size_t SZ_WIN = (size_t)INW * DM * 2;
constexpr size_t WS_WGLU = WS_WIN + NL * SZ_WIN;                            constexpr size_t SZ_WGLU = (size_t)1024 * 512 * 2;
constexpr size_t WS_WPOOL = WS_WGLU + NL * SZ_WGLU;                         constexpr size_t SZ_WPOOL = (size_t)512 * 512 * 2;
constexpr size_t WS_WBR = WS_WPOOL + NL * SZ_WPOOL;                         constexpr size_t SZ_WBR = (size_t)1024 * 512 * 2;
constexpr size_t WS_WO = WS_WBR + NL * 3 * SZ_WBR;                          constexpr size_t SZ_WSQ = (size_t)1024 * 1024 * 2;
constexpr size_t WS_WQ = WS_WO + NL * SZ_WSQ;
constexpr size_t WS_WKV = WS_WQ + NL * SZ_WSQ;                              constexpr size_t SZ_WKV = (size_t)2048 * 1024 * 2;
constexpr size_t WS_WXO = WS_WKV + NL * SZ_WKV;
constexpr size_t WS_WGU = WS_WXO + NL * SZ_WSQ;                             constexpr size_t SZ_WGU = (size_t)2 * DFF * DM * 2;
constexpr size_t WS_WDN = WS_WGU + 2 * SZ_WGU;                              constexpr size_t SZ_WDN = (size_t)DM * DFF * 2;
constexpr size_t WS_MGU = WS_WDN + 2 * SZ_WDN;                              constexpr size_t SZ_MGU = (size_t)2 * DFFE * DM * 2;
constexpr size_t WS_MDN = WS_MGU + 2 * NE * SZ_MGU;                         constexpr size_t SZ_MDN = (size_t)DM * DFFE * 2;
constexpr size_t WS_ROPE = WS_MDN + 2 * NE * SZ_MDN;                        constexpr size_t SZ_ROPE = (size_t)SEQ * 16 * 4;
constexpr size_t WS_PWR = WS_ROPE + SZ_ROPE;                                constexpr size_t SZ_PWR = (size_t)32 * 33 * 64 * 8;
constexpr size_t WS_BBAR = WS_PWR + NL * SZ_PWR;                            constexpr size_t SZ_BBAR = (size_t)32 * 64 * 16 * 8;
constexpr size_t WS_KG = WS_BBAR + NL * SZ_BBAR;                            constexpr size_t SZ_KG = (size_t)32 * 32 * 256 * 4;
constexpr size_t WS_MT = WS_KG + NL * SZ_KG;                                constexpr size_t SZ_MT = (size_t)32 * 512 * 640 * 2;
constexpr size_t WS_PT = WS_MT + NL * SZ_MT;                                constexpr size_t SZ_PT = (size_t)32 * 256 * 512 * 2;
constexpr size_t WS_MEMB = WS_PT + NL * SZ_PT;                              constexpr size_t SZ_MEMB = (size_t)2048 * 1024 * 2;
constexpr size_t WS_KM = WS_MEMB + SZ_MEMB;                                 constexpr size_t SZ_KM = (size_t)2048 * 1024 * 2;
constexpr size_t WS_VT = WS_KM + NL * SZ_KM;                                constexpr size_t SZ_VT = (size_t)8 * 1024 * 256 * 2;
constexpr size_t WS_RTE = WS_VT + NL * SZ_VT;
constexpr size_t WS_RTP = WS_RTE + (size_t)NTOK * 8;
constexpr size_t WS_RTW = WS_RTP + (size_t)NTOK * 8;
constexpr size_t WS_SRC = WS_RTW + (size_t)NTOK * 8;
constexpr size_t WS_WSLOT = WS_SRC + (size_t)NE * NTOK * 4;
constexpr size_t WS_XF = al(WS_WSLOT + (size_t)MOE_ROWS * 4);              constexpr size_t SZ_XF = (size_t)NTOK * DM * 4;
constexpr size_t WS_XB = WS_XF + SZ_XF;                                     constexpr size_t SZ_XB = (size_t)NTOK * DM * 2;
constexpr size_t WS_T = WS_XB + SZ_XB;
constexpr size_t WS_SCR = WS_T + SZ_XF;
constexpr size_t WS_Q = WS_SCR;
constexpr size_t WS_KK = WS_Q + (size_t)NTOK * 512 * 2;
constexpr size_t WS_VV = WS_KK + (size_t)NTOK * 128 * 2;
constexpr size_t WS_U = WS_VV + (size_t)NTOK * 128 * 2;
constexpr size_t WS_UP = WS_U + (size_t)32 * UG_STRIDE * 2;
constexpr size_t WS_GT = WS_UP + (size_t)NTOK * 512 * 2;
constexpr size_t WS_ATTNO = WS_GT + (size_t)NTOK * 3072 * 2;
constexpr size_t WS_YG = WS_ATTNO + (size_t)NTOK * 512 * 2;
constexpr size_t WS_SSMH = WS_YG + (size_t)NTOK * 512 * 2;
constexpr size_t WS_POOLED = WS_SSMH + (size_t)NTOK * 512 * 2;
constexpr size_t WS_MIXED = WS_POOLED + (size_t)NTOK * 512 * 2;
constexpr size_t WS_MERGED = WS_MIXED + (size_t)NTOK * 512 * 2;
constexpr size_t WS_MIX_END = WS_MERGED + (size_t)NTOK * 1024 * 2;
constexpr size_t WS_XQ = WS_SCR;
constexpr size_t WS_PB = WS_XQ + SZ_XB;
constexpr size_t WS_XO = WS_PB + SZ_XB;
constexpr size_t WS_RS = WS_XO + SZ_XB;
constexpr size_t WS_H = WS_SCR;
constexpr size_t WS_XG = WS_H + (size_t)MOE_ROWS * DFFE * 2;
constexpr size_t WS_FFN_END = WS_XG + (size_t)MOE_ROWS * DM * 2;
constexpr size_t WS_FAST_END = al(WS_FFN_END > WS_MIX_END ? WS_FFN_END : WS_MIX_END);

constexpr int LDS_BYTES = 147456, LDS_CTL = 147456 - 512;

DI u32x4 pack8(const f32x4& a, const f32x4& b) { u32x4 w; w.x = pk2(a[0], a[1]); w.y = pk2(a[2], a[3]); w.z = pk2(b[0], b[1]); w.w = pk2(b[2], b[3]); return w; }
#define EPI_ROWS(ai, m) _Pragma("unroll") for (int ai = 0; ai < 2; ++ai) _Pragma("unroll") for (int m = 0; m < 4; ++m)
DI void st16(void* ub, unsigned off, const u32x4& v) { *(u32x4*)((char*)ub + off) = v; }
DI void st16f(void* ub, unsigned off, const f32x4& v) { *(f32x4*)((char*)ub + off) = v; }
DI u32x4 ld16(const void* ub, unsigned off) { return *(const u32x4*)((const char*)ub + off); }
DI f32x4 ld16f(const void* ub, unsigned off) { return *(const f32x4*)((const char*)ub + off); }
DI void mul8(f32x4& v0, f32x4& v1, const u32x4& g) { v0[0] *= bflo(g.x); v0[1] *= bfhi(g.x); v0[2] *= bflo(g.y); v0[3] *= bfhi(g.y); v1[0] *= bflo(g.z); v1[1] *= bfhi(g.z); v1[2] *= bflo(g.w); v1[3] *= bfhi(g.w); }
DI void add8(f32x4& v0, f32x4& v1, const u32x4& g) { v0[0] += bflo(g.x); v0[1] += bfhi(g.x); v0[2] += bflo(g.y); v0[3] += bfhi(g.y); v1[0] += bflo(g.z); v1[1] += bfhi(g.z); v1[2] += bflo(g.w); v1[3] += bfhi(g.w); }

struct EpiInProj {
    static constexpr bool PERM = true, AFTER_DRAIN = false;
    bf16_t *Q, *KK, *VV, *U, *UP, *GT; const float* bgate; const float* rope;
    DI void operator()(const f32x4 (&acc)[2][2][4][2], const pg::Unit& u, int wr, int wc, int fr, int fq) const {
        const int pn = u.pn, r0 = u.pm * 256 + wr * 64;
        if (pn <= 2) {
            const bool rot = (wc & 1) == 0 && fq < 2; const float sg = fq == 0 ? -1.f : 1.f;
            EPI_ROWS(ai, m) { const int ru = r0 + ai * 128 + m * 16;
                f32x4 c0 = {0.f, 0.f, 0.f, 0.f}, c1 = c0, s0 = c0, s1 = c0;
                if (rot) { const float* cs = rope + (size_t)((ru & (SEQ - 1)) * 16); const unsigned lo = (unsigned)fr * 64u; c0 = ld16f(cs, lo); c1 = ld16f(cs, lo + 16); s0 = ld16f(cs, lo + 32); s1 = ld16f(cs, lo + 48); }
#pragma unroll
                for (int bj = 0; bj < 2; ++bj) { f32x4 v0 = acc[ai][bj][m][0], v1 = acc[ai][bj][m][1];
                    if (pn < 2 || bj == 0) {
                        f32x4 p0, p1;
#pragma unroll
                        for (int j = 0; j < 4; ++j) { p0[j] = __shfl_xor(v0[j], 16); p1[j] = __shfl_xor(v1[j], 16); }
                        if (rot) { v0 = v0 * c0 + sg * (p0 * s0); v1 = v1 * c1 + sg * (p1 * s1); }
                        if (pn < 2) st16(Q + (size_t)ru * 512 + pn * 256 + bj * 128 + wc * 32, (unsigned)(fr * 512 + fq * 8) * 2u, pack8(v0 * QSCALE, v1 * QSCALE));
                        else st16(KK + (size_t)ru * 128 + wc * 32, (unsigned)(fr * 128 + fq * 8) * 2u, pack8(v0, v1));
                    } else st16(VV + (size_t)ru * 128 + wc * 32, (unsigned)(fr * 128 + fq * 8) * 2u, pack8(v0, v1));
                } }
        } else if (pn < 5) {
            EPI_ROWS(ai, m) { const int ru = r0 + ai * 128 + m * 16;
#pragma unroll
                for (int bj = 0; bj < 2; ++bj) { const int cu = (pn - 3) * 256 + bj * 128 + wc * 32;
                    st16(U + (size_t)(cu >> 4) * UG_STRIDE + (size_t)(ru >> 5) * 640 + (ru & 31) * 16, (unsigned)((fq >> 1) * UG_STRIDE + fr * 16 + (fq & 1) * 8) * 2u, pack8(acc[ai][bj][m][0], acc[ai][bj][m][1])); } }
        } else if (pn < 7) {
            EPI_ROWS(ai, m) { const int ru = r0 + ai * 128 + m * 16;
#pragma unroll
                for (int bj = 0; bj < 2; ++bj) st16(UP + (size_t)ru * 512 + (pn - 5) * 256 + bj * 128 + wc * 32, (unsigned)(fr * 512 + fq * 8) * 2u, pack8(acc[ai][bj][m][0], acc[ai][bj][m][1])); }
        } else {
            f32x4 b0[2], b1[2];
#pragma unroll
            for (int bj = 0; bj < 2; ++bj) { const float* bp = bgate + (pn - 7) * 256 + bj * 128 + wc * 32; b0[bj] = ld16f(bp, (unsigned)fq * 32u); b1[bj] = ld16f(bp, (unsigned)fq * 32u + 16u); }
            EPI_ROWS(ai, m) { const int ru = r0 + ai * 128 + m * 16;
#pragma unroll
                for (int bj = 0; bj < 2; ++bj) { f32x4 v0 = acc[ai][bj][m][0] + b0[bj], v1 = acc[ai][bj][m][1] + b1[bj];
#pragma unroll
                    for (int j = 0; j < 4; ++j) { v0[j] = sigmoid_f(v0[j]); v1[j] = sigmoid_f(v1[j]); }
                    st16(GT + (size_t)ru * 3072 + (pn - 7) * 256 + bj * 128 + wc * 32, (unsigned)(fr * 3072 + fq * 8) * 2u, pack8(v0, v1)); } }
        }
    }
};
struct EpiBf16 {
    static constexpr bool PERM = true, AFTER_DRAIN = false;
    bf16_t* O; int ldc; float scale;
    DI void operator()(const f32x4 (&acc)[2][2][4][2], const pg::Unit& u, int wr, int wc, int fr, int fq) const {
        const unsigned lo = (unsigned)(fr * ldc + fq * 8) * 2u;
        EPI_ROWS(ai, m) { bf16_t* ub = O + (size_t)(u.row0 + ai * 128 + wr * 64 + m * 16) * ldc + u.col0 + wc * 32;
#pragma unroll
            for (int bj = 0; bj < 2; ++bj) st16(ub + bj * 128, lo, pack8(acc[ai][bj][m][0] * scale, acc[ai][bj][m][1] * scale)); }
    }
};
template <int ACT> struct EpiGlu {
    static constexpr bool PERM = true, AFTER_DRAIN = false;
    bf16_t* O; int ldc;
    DI void operator()(const f32x4 (&acc)[2][2][4][2], const pg::Unit& u, int wr, int wc, int fr, int fq) const {
        const unsigned lo = (unsigned)(fr * ldc + fq * 8) * 2u;
        EPI_ROWS(ai, m) { bf16_t* ub = O + (size_t)(u.row0 + ai * 128 + wr * 64 + m * 16) * ldc + u.pn * 128 + wc * 32;
            f32x4 o0, o1;
#pragma unroll
            for (int j = 0; j < 4; ++j) {
                if (ACT == 0) { o0[j] = acc[ai][0][m][0][j] * sigmoid_f(acc[ai][1][m][0][j]); o1[j] = acc[ai][0][m][1][j] * sigmoid_f(acc[ai][1][m][1][j]); }
                else { o0[j] = silu_f(acc[ai][0][m][0][j]) * acc[ai][1][m][0][j]; o1[j] = silu_f(acc[ai][0][m][1][j]) * acc[ai][1][m][1][j]; } }
            st16(ub, lo, pack8(o0, o1)); }
    }
};
struct EpiColScale {
    static constexpr bool PERM = true, AFTER_DRAIN = false;
    bf16_t* O; int ldc; const float* sc;
    DI void operator()(const f32x4 (&acc)[2][2][4][2], const pg::Unit& u, int wr, int wc, int fr, int fq) const {
        f32x4 s0[2], s1[2]; const unsigned lo = (unsigned)(fr * ldc + fq * 8) * 2u;
#pragma unroll
        for (int bj = 0; bj < 2; ++bj) { const float* sp = sc + u.col0 + bj * 128 + wc * 32; s0[bj] = ld16f(sp, (unsigned)fq * 32u); s1[bj] = ld16f(sp, (unsigned)fq * 32u + 16u); }
        EPI_ROWS(ai, m) { bf16_t* ub = O + (size_t)(u.row0 + ai * 128 + wr * 64 + m * 16) * ldc + u.col0 + wc * 32;
#pragma unroll
            for (int bj = 0; bj < 2; ++bj) st16(ub + bj * 128, lo, pack8(acc[ai][bj][m][0] * s0[bj], acc[ai][bj][m][1] * s1[bj])); }
    }
};
template <bool ACCUM> struct EpiBranch {
    static constexpr bool PERM = true, AFTER_DRAIN = false;
    const bf16_t* GT; bf16_t* MG; int bidx;
    DI void operator()(const f32x4 (&acc)[2][2][4][2], const pg::Unit& u, int wr, int wc, int fr, int fq) const {
        const unsigned lg = (unsigned)(fr * 3072 + fq * 8) * 2u, lm = (unsigned)(fr * 1024 + fq * 8) * 2u;
        EPI_ROWS(ai, m) { const size_t ru = (size_t)(u.row0 + ai * 128 + wr * 64 + m * 16); const int cu = u.col0 + wc * 32;
#pragma unroll
            for (int bj = 0; bj < 2; ++bj) { f32x4 v0 = acc[ai][bj][m][0], v1 = acc[ai][bj][m][1];
                mul8(v0, v1, ld16(GT + ru * 3072 + bidx * 1024 + cu + bj * 128, lg));
                bf16_t* mp = MG + ru * 1024 + cu + bj * 128;
                if (ACCUM) add8(v0, v1, ld16(mp, lm));
                st16(mp, lm, pack8(v0, v1)); } }
    }
};
struct EpiResid {
    static constexpr bool PERM = false, AFTER_DRAIN = false;
    const float* X; float* T;
    DI void operator()(const f32x4 (&acc)[2][2][4][2], const pg::Unit& u, int wr, int wc, int fr, int fq) const {
        const unsigned lo = (unsigned)(fr * 1024 + fq * 4) * 4u;
        EPI_ROWS(ai, m) { const size_t off = (size_t)(u.row0 + ai * 128 + wr * 64 + m * 16) * 1024 + u.col0 + wc * 32;
#pragma unroll
            for (int bj = 0; bj < 2; ++bj)
#pragma unroll
                for (int n = 0; n < 2; ++n) st16f(T + off + bj * 128 + n * 16, lo, ALPHA * ld16f(X + off + bj * 128 + n * 16, lo) + acc[ai][bj][m][n]); }
    }
};
struct EpiSsmE {
    static constexpr bool PERM = false, AFTER_DRAIN = true;
    bf16_t* U; const float* PWR;
    DI void fused(const f32x4 (&acc)[2][2][4][2], const pg::Unit& u, int wr, int wc, int fr, int fq, LAS unsigned char* lds, int wid, int lane) const {
        LAS float* E = (LAS float*)lds;
        EPI_ROWS(ai, m) { const int r = ai * 128 + wr * 64 + m * 16 + fr;
#pragma unroll
            for (int n = 0; n < 2; ++n) *(LAS f32x4*)(E + r * 132 + wc * 32 + 16 * n + 4 * fq) = acc[ai][0][m][n]; }
        __syncthreads();
        const int t = wid * 64 + lane;
        if (t < 128) { const int bl = t >> 6, n = t & 63, g = u.z;
            const float ar = PWR[((g * 33 + 32) * 64 + n) * 2], ai_ = PWR[((g * 33 + 32) * 64 + n) * 2 + 1];
            float hr = 0.f, hi = 0.f;
            bf16_t* up = U + (size_t)g * UG_STRIDE + (size_t)(u.pm * 256 + bl * 128) * 640 + 512 + 2 * n;
            for (int c = 0; c < 128; ++c) {
                *(unsigned*)(up + (size_t)c * 640) = pk2(hr, hi);
                const f32x2 e = *(const LAS f32x2*)(E + (bl * 128 + c) * 132 + 2 * n);
                const float nr = ar * hr - ai_ * hi + e.x, ni = ar * hi + ai_ * hr + e.y; hr = nr; hi = ni; }
        }
        __syncthreads();
    }
};
struct EpiSsmY {
    static constexpr bool PERM = true, AFTER_DRAIN = false;
    bf16_t* YG;
    DI void operator()(const f32x4 (&acc)[2][2][4][2], const pg::Unit& u, int wr, int wc, int fr, int fq) const {
        const unsigned lo = (unsigned)((fr * 32 + (fq >> 1)) * 512 + (fq & 1) * 8) * 2u;
        EPI_ROWS(ai, m) { const int ru = u.pm * 256 + ai * 128 + wr * 64 + m * 16;
#pragma unroll
            for (int bj = 0; bj < 2; ++bj) { const int cu = u.pn * 256 + bj * 128 + wc * 32;
                f32x4 v0 = acc[ai][bj][m][0], v1 = acc[ai][bj][m][1];
#pragma unroll
                for (int j = 0; j < 4; ++j) { v0[j] = gelu_tanh_f(v0[j]); v1[j] = gelu_tanh_f(v1[j]); }
                st16(YG + ((size_t)ru * 32 + (cu >> 4)) * 512 + u.z * 16, lo, pack8(v0, v1)); } }
    }
};
struct EpiSexp {
    static constexpr bool PERM = true, AFTER_DRAIN = false;
    bf16_t* PB; float* RS;
    DI void operator()(const f32x4 (&acc)[2][2][4][2], const pg::Unit& u, int wr, int wc, int fr, int fq) const {
        const unsigned lo = (unsigned)(fr * 1024 + fq * 8) * 2u;
        EPI_ROWS(ai, m) { const size_t ru = (size_t)(u.row0 + ai * 128 + wr * 64 + m * 16); float s = 0.f;
#pragma unroll
            for (int bj = 0; bj < 2; ++bj) { f32x4 v0 = acc[ai][bj][m][0], v1 = acc[ai][bj][m][1];
#pragma unroll
                for (int j = 0; j < 4; ++j) { v0[j] = fast_exp2(fminf(v0[j], 100.f)); v1[j] = fast_exp2(fminf(v1[j], 100.f)); }
                const u32x4 w = pack8(v0, v1);
                s += (bflo(w.x) + bfhi(w.x)) + (bflo(w.y) + bfhi(w.y)) + (bflo(w.z) + bfhi(w.z)) + (bflo(w.w) + bfhi(w.w));
                st16(PB + ru * 1024 + u.col0 + bj * 128 + wc * 32, lo, w); }
            s += __shfl_xor(s, 16); s += __shfl_xor(s, 32);
            if (fq == 0) *(float*)((char*)(RS + (ru * 4 + (u.col0 >> 8)) * 4 + wc) + (unsigned)fr * 64u) = s; }
    }
};
struct EpiPv {
    static constexpr bool PERM = true, AFTER_DRAIN = false;
    bf16_t* XO; const float* RS;
    DI void operator()(const f32x4 (&acc)[2][2][4][2], const pg::Unit& u, int wr, int wc, int fr, int fq) const {
        const unsigned lo = (unsigned)(fr * 1024 + fq * 8) * 2u;
        EPI_ROWS(ai, m) { const size_t ru = (size_t)(u.row0 + ai * 128 + wr * 64 + m * 16);
            const f32x4 rs = ld16f(RS + (ru * 4 + (u.col0 >> 8)) * 4, (unsigned)fr * 64u); const float inv = 1.f / ((rs[0] + rs[1]) + (rs[2] + rs[3]));
#pragma unroll
            for (int bj = 0; bj < 2; ++bj) st16(XO + ru * 1024 + u.col0 + bj * 128 + wc * 32, lo, pack8(acc[ai][bj][m][0] * inv, acc[ai][bj][m][1] * inv)); }
    }
};
struct EpiMoeDown {
    static constexpr bool PERM = true, AFTER_DRAIN = false;
    bf16_t* Y; const float* wslot;
    DI void operator()(const f32x4 (&acc)[2][2][4][2], const pg::Unit& u, int wr, int wc, int fr, int fq) const {
        const unsigned lo = (unsigned)(fr * 1024 + fq * 8) * 2u;
        EPI_ROWS(ai, m) { const size_t ru = (size_t)(u.row0 + ai * 128 + wr * 64 + m * 16); const float w = *(const float*)((const char*)(wslot + ru) + (unsigned)fr * 4u);
#pragma unroll
            for (int bj = 0; bj < 2; ++bj) st16(Y + ru * 1024 + u.col0 + bj * 128 + wc * 32, lo, pack8(acc[ai][bj][m][0] * w, acc[ai][bj][m][1] * w)); }
    }
};
}
namespace fp {
constexpr int CW_BARBASE = 65536, CW_BARSTRIDE = 4096;
constexpr size_t WS_WL = WS_FAST_END;
constexpr size_t WS_FAST_END2 = al(WS_WL + (size_t)NE * NTOK * 4);

struct Args { const float* in[35]; float* out; unsigned char* ws; int ph_lo, ph_hi, bar_region, pad; };

struct Ctx { int tid, lane, wave, G, vcu, gw, NGW, gt, NGT; LAS unsigned char* lds; };

template <int MAP> DI int map_row(int n0, int F) { if (MAP == 0) return n0; return n0 < F ? (n0 / 128) * 256 + (n0 % 128) : ((n0 - F) / 128) * 256 + 128 + ((n0 - F) % 128); }
template <int MAP> DI void transpose_item(const float* W, int K, int N, bf16_t* WT, int dld, int dcol0, int drow0, int F, LAS float* scr, int item, int lane) {
    const int nblk = N / 32, kb = item / nblk, nb = item % nblk, k0 = 64 * kb, n0 = 32 * nb;
#pragma unroll 8
    for (int i = 0; i < 32; ++i) { const int kk = 2 * i + (lane >> 5); scr[kk * 33 + (lane & 31)] = W[(size_t)(k0 + kk) * N + n0 + (lane & 31)]; }
    asm volatile("s_waitcnt lgkmcnt(0)" ::: "memory");
    const int c = lane & 7, dr = drow0 + map_row<MAP>(n0, F);
#pragma unroll
    for (int j = 0; j < 4; ++j) { const int n = (lane >> 3) + 8 * j; const LAS float* s = scr + (8 * c) * 33 + n;
        u32x4 o; o.x = pk2(s[0 * 33], s[1 * 33]); o.y = pk2(s[2 * 33], s[3 * 33]); o.z = pk2(s[4 * 33], s[5 * 33]); o.w = pk2(s[6 * 33], s[7 * 33]);
        *(u32x4*)(WT + (size_t)(dr + n) * dld + dcol0 + k0 + 8 * c) = o; }
    asm volatile("s_waitcnt lgkmcnt(0)" ::: "memory");
}
template <int MAP> DI void transpose_mats(const Ctx& C, const float* src, size_t sstr, int nmat, int K, int N, bf16_t* dst, size_t dstr, int F) {
    LAS float* scr = (LAS float*)(C.lds + C.wave * 16384);
    const int per = (K / 64) * (N / 32);
    for (int it = C.gw; it < nmat * per; it += C.NGW) { const int mt = it / per, r = it % per; transpose_item<MAP>(src + (size_t)mt * sstr, K, N, dst + (size_t)mt * dstr, K, 0, 0, F, scr, r, C.lane); }
}
DI void reduce_2pi(double ang, float& s, float& c) { const double k = rint(ang * 0.15915494309189535); const float r = (float)(ang - k * 6.283185307179586); sincosf(r, &s, &c); }

DI void prologue_a(const Ctx& C, const Args& a) {
    unsigned char* ws = a.ws;
    transpose_mats<0>(C, a.in[2], (size_t)DM * INW, NL, DM, INW, (bf16_t*)(ws + WS_WIN), (size_t)INW * DM, 0);
    transpose_mats<1>(C, a.in[13], (size_t)512 * 1024, NL, 512, 1024, (bf16_t*)(ws + WS_WGLU), (size_t)1024 * 512, 512);
    for (int b = 0; b < 3; ++b) transpose_mats<0>(C, a.in[16 + b], (size_t)512 * 1024, NL, 512, 1024, (bf16_t*)(ws + WS_WBR) + (size_t)b * 1024 * 512, (size_t)3 * 1024 * 512, 0);
    transpose_mats<0>(C, a.in[19], (size_t)DM * DM, NL, DM, DM, (bf16_t*)(ws + WS_WO), (size_t)DM * DM, 0);
    transpose_mats<0>(C, a.in[22], (size_t)DM * DM, NL, DM, DM, (bf16_t*)(ws + WS_WQ), (size_t)DM * DM, 0);
    transpose_mats<0>(C, a.in[23], (size_t)DM * 2048, NL, DM, 2048, (bf16_t*)(ws + WS_WKV), (size_t)2048 * DM, 0);
    transpose_mats<0>(C, a.in[24], (size_t)DM * DM, NL, DM, DM, (bf16_t*)(ws + WS_WXO), (size_t)DM * DM, 0);
    transpose_mats<1>(C, a.in[27], (size_t)DM * 2 * DFF, 2, DM, 2 * DFF, (bf16_t*)(ws + WS_WGU), (size_t)2 * DFF * DM, DFF);
    transpose_mats<0>(C, a.in[28], (size_t)DFF * DM, 2, DFF, DM, (bf16_t*)(ws + WS_WDN), (size_t)DM * DFF, 0);
    transpose_mats<1>(C, a.in[31], (size_t)DM * 2 * DFFE, 2 * NE, DM, 2 * DFFE, (bf16_t*)(ws + WS_MGU), (size_t)2 * DFFE * DM, DFFE);
    transpose_mats<0>(C, a.in[32], (size_t)DFFE * DM, 2 * NE, DFFE, DM, (bf16_t*)(ws + WS_MDN), (size_t)DM * DFFE, 0);
    { LAS float* scr = (LAS float*)(C.lds + C.wave * 16384);
      for (int it = C.gw; it < NL * 4 * 8; it += C.NGW) { const int lg = it >> 3, r = it & 7, L = lg >> 2, g = lg & 3;
          transpose_item<0>(a.in[14] + (size_t)lg * 128 * 128, 128, 128, (bf16_t*)(ws + WS_WPOOL) + (size_t)L * 512 * 512, 512, g * 128, g * 128, 0, scr, r, C.lane); }
      for (int p = C.gt; p < NL * 512 * 64; p += C.NGT) { const int L = p >> 15, n = (p >> 6) & 511, k8 = p & 63;
          if ((n >> 7) != (k8 >> 4)) *(u32x4*)((bf16_t*)(ws + WS_WPOOL) + ((size_t)L * 512 + n) * 512 + k8 * 8) = (u32x4){0u, 0u, 0u, 0u}; } }
    for (int p = C.gt; p < SEQ * 8; p += C.NGT) { const int pos = p >> 3, i = p & 7; const float inv = powf(500000.0f, -(float)i / 8.0f), ang = (float)pos * inv; float s, c; sincosf(ang, &s, &c);
        float* r = (float*)(ws + WS_ROPE) + (size_t)pos * 16; r[i] = c; r[8 + i] = s; }
    for (int p = C.gt; p < 2048 * 1024 / 8; p += C.NGT) { const f32x4 v0 = *(const f32x4*)(a.in[1] + (size_t)p * 8), v1 = *(const f32x4*)(a.in[1] + (size_t)p * 8 + 4); *(u32x4*)((bf16_t*)(ws + WS_MEMB) + (size_t)p * 8) = pack8(v0, v1); }
    for (int p = C.gt; p < NTOK * DM / 8; p += C.NGT) { const f32x4 v0 = *(const f32x4*)(a.in[0] + (size_t)p * 8), v1 = *(const f32x4*)(a.in[0] + (size_t)p * 8 + 4); *(u32x4*)((bf16_t*)(ws + WS_XB) + (size_t)p * 8) = pack8(v0, v1); }
    { LAS float* W = (LAS float*)(C.lds + C.wave * 16384);
      for (int it = C.gw; it < NL * 32 * 33; it += C.NGW) { const int L = it / (32 * 33), r = it % (32 * 33), g = r / 33, tau = r % 33, n = C.lane;
          const float ar = a.in[5][(L * 32 + g) * 64 + n], ai = a.in[6][(L * 32 + g) * 64 + n], dt = expf(a.in[7][L * 32 + g]);
          float pr, pi; { const float mag = expf((float)tau * dt * ar); float s, c; reduce_2pi((double)tau * (double)dt * (double)ai, s, c); pr = mag * c; pi = mag * s; }
          float* pw = (float*)(ws + WS_PWR + (size_t)L * SZ_PWR) + ((size_t)(g * 33 + tau) * 64 + n) * 2; pw[0] = pr; pw[1] = pi;
          if (tau < 32) {
              float abr, abi; { const float mag = expf(dt * ar); float s, c; reduce_2pi((double)dt * (double)ai, s, c); abr = mag * c; abi = mag * s; }
              const float inv = 1.f / (ar * ar + ai * ai), nr = abr - 1.f, ni = abi, fr = (nr * ar + ni * ai) * inv, fi = (ni * ar - nr * ai) * inv;
              const float* bre = a.in[8] + ((size_t)(L * 32 + g) * 64 + n) * 16; const float* bim = a.in[9] + ((size_t)(L * 32 + g) * 64 + n) * 16;
              float* bb = (float*)(ws + WS_BBAR + (size_t)L * SZ_BBAR) + ((size_t)g * 64 + n) * 32;
#pragma unroll
              for (int j = 0; j < 16; ++j) { const float br = bre[j], bi = bim[j], xr = fr * br - fi * bi, xi = fr * bi + fi * br;
                  if (tau == 0) { bb[2 * j] = xr; bb[2 * j + 1] = xi; }
                  W[(n * 16 + j) * 2] = pr * xr - pi * xi; W[(n * 16 + j) * 2 + 1] = pr * xi + pi * xr; }
              asm volatile("s_waitcnt lgkmcnt(0)" ::: "memory");
              const float* cre = a.in[10] + (size_t)(L * 32 + g) * 16 * 64; const float* cim = a.in[11] + (size_t)(L * 32 + g) * 16 * 64;
              float* kg = (float*)(ws + WS_KG + (size_t)L * SZ_KG) + (size_t)(g * 32 + tau) * 256;
#pragma unroll
              for (int q = 0; q < 4; ++q) { const int o = C.lane + 64 * q, p = o >> 4, j = o & 15; float s = 0.f;
                  for (int k = 0; k < 64; ++k) s += cre[p * 64 + k] * W[(k * 16 + j) * 2] - cim[p * 64 + k] * W[(k * 16 + j) * 2 + 1];
                  if (tau == 0 && p == j) s += a.in[12][L * 512 + g * 16 + p];
                  kg[o] = s; }
              asm volatile("s_waitcnt lgkmcnt(0)" ::: "memory");
          } } }
}
DI void prologue_b_tables(const Ctx& C, const Args& a) {
    unsigned char* ws = a.ws;
    for (int p = C.gt; p < NL * 32 * 512 * 80; p += C.NGT) { const int c8 = p % 80, rr = p / 80, r = rr & 511, lg = rr >> 9, L = lg >> 5, g = lg & 31, t = r >> 4, pp = r & 15;
        f32x4 v0 = {0.f, 0.f, 0.f, 0.f}, v1 = {0.f, 0.f, 0.f, 0.f};
        if (c8 < 64) { const int s = c8 >> 1, j0 = (c8 & 1) * 8;
            if (s <= t) { const float* kg = (const float*)(ws + WS_KG + (size_t)L * SZ_KG) + ((size_t)(g * 32 + (t - s)) * 16 + pp) * 16 + j0; v0 = *(const f32x4*)kg; v1 = *(const f32x4*)(kg + 4); } }
        else { const int n0 = (c8 - 64) * 4; const float* cre = a.in[10] + ((size_t)(L * 32 + g) * 16 + pp) * 64 + n0; const float* cim = a.in[11] + ((size_t)(L * 32 + g) * 16 + pp) * 64 + n0;
            const float* pw = (const float*)(ws + WS_PWR + (size_t)L * SZ_PWR) + ((size_t)(g * 33 + t + 1) * 64 + n0) * 2;
            float o[8];
#pragma unroll
            for (int i = 0; i < 4; ++i) { const float cr = cre[i], ci = cim[i], pr = pw[2 * i], pi = pw[2 * i + 1]; o[2 * i] = cr * pr - ci * pi; o[2 * i + 1] = -(cr * pi + ci * pr); }
            v0 = (f32x4){o[0], o[1], o[2], o[3]}; v1 = (f32x4){o[4], o[5], o[6], o[7]}; }
        *(u32x4*)((bf16_t*)(ws + WS_MT + (size_t)L * SZ_MT) + ((size_t)g * 512 + r) * 640 + c8 * 8) = pack8(v0, v1); }
    for (int p = C.gt; p < NL * 32 * 256 * 64; p += C.NGT) { const int c8 = p & 63, n2 = (p >> 6) & 255, lg = p >> 14, L = lg >> 5, g = lg & 31;
        f32x4 v0 = {0.f, 0.f, 0.f, 0.f}, v1 = {0.f, 0.f, 0.f, 0.f};
        if (n2 < 128) { const int n = n2 >> 1, im = n2 & 1, s = c8 >> 1, j0 = (c8 & 1) * 8;
            const float* pw = (const float*)(ws + WS_PWR + (size_t)L * SZ_PWR) + ((size_t)(g * 33 + (31 - s)) * 64 + n) * 2; const float pr = pw[0], pi = pw[1];
            const float* bb = (const float*)(ws + WS_BBAR + (size_t)L * SZ_BBAR) + ((size_t)g * 64 + n) * 32 + j0 * 2;
            float o[8];
#pragma unroll
            for (int i = 0; i < 8; ++i) { const float xr = bb[2 * i], xi = bb[2 * i + 1]; o[i] = im ? (pr * xi + pi * xr) : (pr * xr - pi * xi); }
            v0 = (f32x4){o[0], o[1], o[2], o[3]}; v1 = (f32x4){o[4], o[5], o[6], o[7]}; }
        *(u32x4*)((bf16_t*)(ws + WS_PT + (size_t)L * SZ_PT) + ((size_t)g * 256 + n2) * 512 + c8 * 8) = pack8(v0, v1); }
}

template <int MODE, bool ROUTE>
DI void ln_phase(const Ctx& C, const float* T, const float* X, const float* gam, const float* bet, float* XFo, bf16_t* XBo,
                 const bf16_t* Y, const int* rte, const int* rtp, const unsigned* cntw,
                 const float* wr, const float* brt, int* rte_o, int* rtp_o, float* rtw_o, int* src_o, float* wl_o, unsigned* cnt_o) {
    f32x4 gg[4], bb[4];
#pragma unroll
    for (int j = 0; j < 4; ++j) { gg[j] = *(const f32x4*)(gam + j * 256 + C.lane * 4); bb[j] = *(const f32x4*)(bet + j * 256 + C.lane * 4); }
    int base[8];
    if (MODE == 1) { int acc = 0;
#pragma unroll
        for (int e = 0; e < 8; ++e) { base[e] = acc; acc += (int)((cntw[e * 64] + 255u) & ~255u); } }
    LAS float* wT = (LAS float*)C.lds;
    if (ROUTE) { for (int i = C.tid; i < 8192; i += 512) { const int k = i >> 3, e = i & 7; wT[e * 1024 + k] = wr[i]; } __syncthreads(); }
    for (int row = C.gw; row < NTOK; row += C.NGW) {
        f32x4 v[4]; float s = 0.f;
        if (MODE == 0) {
#pragma unroll
            for (int j = 0; j < 4; ++j) v[j] = *(const f32x4*)(T + (size_t)row * 1024 + j * 256 + C.lane * 4);
        } else {
            const int e0 = rte[row * 2], e1 = rte[row * 2 + 1], p0 = rtp[row * 2], p1 = rtp[row * 2 + 1];
            int b0 = 0, b1 = 0;
#pragma unroll
            for (int e = 0; e < 8; ++e) { b0 = e == e0 ? base[e] : b0; b1 = e == e1 ? base[e] : b1; }
            const bf16_t* ya = Y + (size_t)(b0 + p0) * 1024; const bf16_t* yb = Y + (size_t)(b1 + p1) * 1024;
#pragma unroll
            for (int j = 0; j < 4; ++j) { const f32x4 x = *(const f32x4*)(X + (size_t)row * 1024 + j * 256 + C.lane * 4);
                const u32x2 wa = *(const u32x2*)(ya + j * 256 + C.lane * 4), wb = *(const u32x2*)(yb + j * 256 + C.lane * 4);
                v[j][0] = ALPHA * x[0] + bflo(wa.x) + bflo(wb.x); v[j][1] = ALPHA * x[1] + bfhi(wa.x) + bfhi(wb.x); v[j][2] = ALPHA * x[2] + bflo(wa.y) + bflo(wb.y); v[j][3] = ALPHA * x[3] + bfhi(wa.y) + bfhi(wb.y); }
        }
#pragma unroll
        for (int j = 0; j < 4; ++j) s += (v[j][0] + v[j][1]) + (v[j][2] + v[j][3]);
        const float mean = wave_sum(s) * (1.f / 1024.f); float q = 0.f;
#pragma unroll
        for (int j = 0; j < 4; ++j) { v[j] = v[j] - mean; q += (v[j][0] * v[j][0] + v[j][1] * v[j][1]) + (v[j][2] * v[j][2] + v[j][3] * v[j][3]); }
        const float rstd = rsqrtf(wave_sum(q) * (1.f / 1024.f) + LN_EPS);
#pragma unroll
        for (int j = 0; j < 4; ++j) { v[j] = v[j] * rstd * gg[j] + bb[j];
            *(f32x4*)(XFo + (size_t)row * 1024 + j * 256 + C.lane * 4) = v[j];
            u32x2 w; w.x = pk2(v[j][0], v[j][1]); w.y = pk2(v[j][2], v[j][3]); *(u32x2*)(XBo + (size_t)row * 1024 + j * 256 + C.lane * 4) = w; }
        if (ROUTE) {
            float lg[8];
#pragma unroll
            for (int e = 0; e < 8; ++e) { float t = 0.f;
#pragma unroll
                for (int j = 0; j < 4; ++j) { const f32x4 w = *(const LAS f32x4*)(wT + e * 1024 + j * 256 + C.lane * 4); t += (v[j][0] * w[0] + v[j][1] * w[1]) + (v[j][2] * w[2] + v[j][3] * w[3]); }
                lg[e] = wave_sum(t) + brt[e]; }
            int i1 = 0; float v1 = lg[0];
#pragma unroll
            for (int e = 1; e < 8; ++e) if (lg[e] > v1) { v1 = lg[e]; i1 = e; }
            int i2 = 0; float v2 = -3.0e38f;
#pragma unroll
            for (int e = 0; e < 8; ++e) if (e != i1 && lg[e] > v2) { v2 = lg[e]; i2 = e; }
            const float w2 = 1.f / (1.f + expf(v1 - v2)), w1 = 1.f - w2;
            if (C.lane == 0) {
                const int p1 = (int)__hip_atomic_fetch_add(cnt_o + i1 * 64, 1u, RLX_AGENT), p2 = (int)__hip_atomic_fetch_add(cnt_o + i2 * 64, 1u, RLX_AGENT);
                rte_o[row * 2] = i1; rte_o[row * 2 + 1] = i2; rtp_o[row * 2] = p1; rtp_o[row * 2 + 1] = p2; rtw_o[row * 2] = w1; rtw_o[row * 2 + 1] = w2;
                src_o[(size_t)i1 * NTOK + p1] = row; src_o[(size_t)i2 * NTOK + p2] = row; wl_o[(size_t)i1 * NTOK + p1] = w1; wl_o[(size_t)i2 * NTOK + p2] = w2;
            }
        }
    }
    if (ROUTE) __syncthreads();
}

DI void pool_phase(const Ctx& C, const bf16_t* UP, bf16_t* PO) {
    for (int p = C.gt; p < NTOK * 64; p += C.NGT) { const int row = p >> 6, c8 = p & 63, w = 2 << (c8 >> 4), t = row & (SEQ - 1), cnt = t + 1 < w ? t + 1 : w;
        float s[8], u0[8];
#pragma unroll
        for (int i = 0; i < 8; ++i) s[i] = 0.f;
        for (int j = 0; j < cnt; ++j) { const u32x4 x = *(const u32x4*)(UP + (size_t)(row - j) * 512 + c8 * 8);
            const float f[8] = {bflo(x.x), bfhi(x.x), bflo(x.y), bfhi(x.y), bflo(x.z), bfhi(x.z), bflo(x.w), bfhi(x.w)};
#pragma unroll
            for (int i = 0; i < 8; ++i) { s[i] += f[i]; if (j == 0) u0[i] = f[i]; } }
        const float inv = 1.f / (float)cnt; f32x4 v0, v1;
#pragma unroll
        for (int i = 0; i < 4; ++i) { v0[i] = s[i] * inv - u0[i]; v1[i] = s[4 + i] * inv - u0[4 + i]; }
        *(u32x4*)(PO + (size_t)row * 512 + c8 * 8) = pack8(v0, v1); }
}

DI void moe_gather_phase(const Ctx& C, const unsigned* cntw, const int* src, const float* wl, const bf16_t* XB, bf16_t* XG, float* WSLOT) {
    int base[9]; { int acc = 0;
#pragma unroll
        for (int e = 0; e < 8; ++e) { base[e] = acc; acc += (int)((cntw[e * 64] + 255u) & ~255u); } base[8] = acc; }
    for (int s = C.gw; s < base[8]; s += C.NGW) {
        int e = 0;
#pragma unroll
        for (int k = 1; k < 8; ++k) e = s >= base[k] ? k : e;
        int be = 0;
#pragma unroll
        for (int k = 0; k < 8; ++k) be = k == e ? base[k] : be;
        const int pos = s - be; const bool valid = pos < (int)cntw[e * 64];
        u32x4 v0 = {0u, 0u, 0u, 0u}, v1 = {0u, 0u, 0u, 0u}; float w = 0.f;
        if (valid) { const int r = src[(size_t)e * NTOK + pos]; w = wl[(size_t)e * NTOK + pos];
            v0 = *(const u32x4*)(XB + (size_t)r * 1024 + C.lane * 16); v1 = *(const u32x4*)(XB + (size_t)r * 1024 + C.lane * 16 + 8); }
        *(u32x4*)(XG + (size_t)s * 1024 + C.lane * 16) = v0; *(u32x4*)(XG + (size_t)s * 1024 + C.lane * 16 + 8) = v1;
        if (C.lane == 0) WSLOT[s] = w;
    }
}

constexpr int KS_STRIDE = 72, VT_STRIDE = 264;
DI void swa_phase(const Ctx& C, const bf16_t* Q, const bf16_t* KK, const bf16_t* VV, const float* sinks, bf16_t* AO) {
    LAS bf16_t* Ks = (LAS bf16_t*)C.lds; LAS bf16_t* Vt = Ks + 256 * KS_STRIDE;
    const int r = C.lane & 31, h = C.lane >> 5;
    for (int un = blockIdx.x; un < 8 * 2 * 32; un += C.G) {
        const int qb = un & 31, kvh = (un >> 5) & 1, b = un >> 6;
        const int k0 = qb * 128 - 128;
        __syncthreads();
#pragma unroll
        for (int i = 0; i < 4; ++i) { const int p = C.tid + 512 * i, key = p >> 3, part = p & 7, pos = k0 + key;
            u32x4 kv = {0u, 0u, 0u, 0u}, vv = {0u, 0u, 0u, 0u};
            if (pos >= 0) { const size_t g = (size_t)(b * SEQ + pos) * 128 + kvh * 64 + part * 8; kv = *(const u32x4*)(KK + g); vv = *(const u32x4*)(VV + g); }
            *(LAS u32x4*)(Ks + key * KS_STRIDE + part * 8) = kv;
            const unsigned vw[4] = {vv.x, vv.y, vv.z, vv.w};
#pragma unroll
            for (int j = 0; j < 4; ++j) { Vt[(part * 8 + 2 * j) * VT_STRIDE + key] = (bf16_t)(vw[j] & 0xffffu); Vt[(part * 8 + 2 * j + 1) * VT_STRIDE + key] = (bf16_t)(vw[j] >> 16); } }
        __syncthreads();
#pragma unroll 1
        for (int rep = 0; rep < 2; ++rep) {
            const int it = C.wave + 8 * rep, g4 = it >> 2, q0 = (it & 3) * 32, head = kvh * 4 + g4;
            const size_t tok = (size_t)b * SEQ + qb * 128 + q0 + r;
            bf16x8 qf[4];
#pragma unroll
            for (int ks = 0; ks < 4; ++ks) qf[ks] = *(const bf16x8*)(Q + tok * 512 + head * 64 + ks * 16 + h * 8);
            const float sink2 = sinks[head] * LOG2E;
            float m = sink2, l = 1.f;
            f32x16 o0, o1;
#pragma unroll
            for (int i = 0; i < 16; ++i) { o0[i] = 0.f; o1[i] = 0.f; }
#pragma unroll 1
            for (int kb = 0; kb < 5; ++kb) {
                f32x16 x;
#pragma unroll
                for (int i = 0; i < 16; ++i) x[i] = 0.f;
                const LAS bf16_t* kp = Ks + (q0 + kb * 32 + r) * KS_STRIDE + h * 8;
#pragma unroll
                for (int ks = 0; ks < 4; ++ks) { const bf16x8 kf = *(const LAS bf16x8*)(kp + ks * 16); x = __builtin_amdgcn_mfma_f32_32x32x16_bf16(kf, qf[ks], x, 0, 0, 0); }
                float bm = -1.0e30f; const int relb = 128 + r - kb * 32 - 4 * h, posb = k0 + q0 + kb * 32 + 4 * h;
#pragma unroll
                for (int i = 0; i < 16; ++i) { const int cr = (i & 3) + 8 * (i >> 2); const int rel = relb - cr; const bool ok = rel >= 0 && rel < 128 && (posb + cr) >= 0;
                    x[i] = ok ? x[i] : -1.0e30f; bm = fmaxf(bm, x[i]); }
                bm = fmaxf(bm, __shfl_xor(bm, 32));
                const float mn = fmaxf(m, bm), sc = fast_exp2(m - mn); m = mn;
                float ps = 0.f;
#pragma unroll
                for (int i = 0; i < 16; ++i) { x[i] = fast_exp2(x[i] - mn); ps += x[i]; }
                ps += __shfl_xor(ps, 32);
                l = l * sc + ps;
#pragma unroll
                for (int i = 0; i < 16; ++i) { o0[i] *= sc; o1[i] *= sc; }
#pragma unroll
                for (int s2 = 0; s2 < 2; ++s2) { u32x4 pw; pw.x = pk2(x[8 * s2], x[8 * s2 + 1]); pw.y = pk2(x[8 * s2 + 2], x[8 * s2 + 3]); pw.z = pk2(x[8 * s2 + 4], x[8 * s2 + 5]); pw.w = pk2(x[8 * s2 + 6], x[8 * s2 + 7]);
                    const bf16x8 pf = __builtin_bit_cast(bf16x8, pw);
                    const LAS bf16_t* vp = Vt + r * VT_STRIDE + q0 + kb * 32 + 16 * s2 + 4 * h;
                    { const s16x4 lo = *(const LAS s16x4*)vp, hi = *(const LAS s16x4*)(vp + 8); const bf16x8 vf = __builtin_shufflevector(lo, hi, 0, 1, 2, 3, 4, 5, 6, 7); o0 = __builtin_amdgcn_mfma_f32_32x32x16_bf16(vf, pf, o0, 0, 0, 0); }
                    { const s16x4 lo = *(const LAS s16x4*)(vp + 32 * VT_STRIDE), hi = *(const LAS s16x4*)(vp + 32 * VT_STRIDE + 8); const bf16x8 vf = __builtin_shufflevector(lo, hi, 0, 1, 2, 3, 4, 5, 6, 7); o1 = __builtin_amdgcn_mfma_f32_32x32x16_bf16(vf, pf, o1, 0, 0, 0); } }
            }
            const float inv = 1.f / l;
            bf16_t* ao = AO + tok * 512 + head * 64 + 4 * h;
#pragma unroll
            for (int g = 0; g < 4; ++g) { u32x2 w; w.x = pk2(o0[4 * g] * inv, o0[4 * g + 1] * inv); w.y = pk2(o0[4 * g + 2] * inv, o0[4 * g + 3] * inv); *(u32x2*)(ao + 8 * g) = w; }
#pragma unroll
            for (int g = 0; g < 4; ++g) { u32x2 w; w.x = pk2(o1[4 * g] * inv, o1[4 * g + 1] * inv); w.y = pk2(o1[4 * g + 2] * inv, o1[4 * g + 3] * inv); *(u32x2*)(ao + 32 + 8 * g) = w; }
        }
    }
    __syncthreads();
}

struct KvOrder {
    const char* MEMB; const char* WKV; int G, c;
    DI bool next(int i, pg::Unit& u) const { const int q = i * G + c; if (q >= 256) return false; const int L = q >> 6, r = q & 63; const char* wkv = WKV + (size_t)L * SZ_WKV;
        if (r < 32) { u.pm = r >> 2; u.pn = r & 3; u.z = 0; u.row0 = L * 2048 + u.pm * 256; u.col0 = u.pn * 256; u.a = MEMB + (size_t)u.pm * 256 * 2048; u.b = wkv + (size_t)u.pn * 256 * 2048; }
        else { const int bb = (r - 32) >> 2; u.pm = (r - 32) & 3; u.pn = 0; u.z = 1; u.row0 = (L * 8 + bb) * 1024 + u.pm * 256; u.col0 = 0; u.a = wkv + (size_t)(1024 + u.pm * 256) * 2048; u.b = MEMB + (size_t)bb * 256 * 2048; }
        return true; }
};
struct EpiKv {
    static constexpr bool PERM = true, AFTER_DRAIN = false;
    bf16_t *KM, *VT;
    DI void operator()(const f32x4 (&acc)[2][2][4][2], const pg::Unit& u, int wr, int wc, int fr, int fq) const {
        bf16_t* O = u.z ? VT : KM; const int ldc = u.z ? 256 : 1024; const unsigned lo = (unsigned)(fr * ldc + fq * 8) * 2u;
        EPI_ROWS(ai, m) { bf16_t* ub = O + (size_t)(u.row0 + ai * 128 + wr * 64 + m * 16) * ldc + u.col0 + wc * 32;
#pragma unroll
            for (int bj = 0; bj < 2; ++bj) st16(ub + bj * 128, lo, pack8(acc[ai][bj][m][0], acc[ai][bj][m][1])); }
    }
};
struct SsmEOrder {
    const char* U; const char* PT; int G, c;
    DI bool next(int i, pg::Unit& u) const { const int q = i * G + c; if (q >= 128) return false; u.z = q >> 2; u.pm = q & 3; u.pn = 0; u.row0 = u.pm * 256; u.col0 = 0;
        u.a = U + ((size_t)u.z * UG_STRIDE + (size_t)u.pm * 256 * 640) * 2; u.b = PT + (size_t)u.z * 256 * 512 * 2; return true; }
};
struct SsmYOrder {
    const char* U; const char* MT; int G, c;
    DI bool next(int i, pg::Unit& u) const { const int q = i * G + c; if (q >= 256) return false; u.z = q >> 3; u.pm = (q >> 1) & 3; u.pn = q & 1; u.row0 = u.pm * 256; u.col0 = u.pn * 256;
        u.a = U + ((size_t)u.z * UG_STRIDE + (size_t)u.pm * 256 * 640) * 2; u.b = MT + ((size_t)u.z * 512 + u.pn * 256) * 640 * 2; return true; }
};
struct XsOrder {
    const char* XQ; const char* KM; int G, c;
    DI bool next(int i, pg::Unit& u) const { const int q = i * G + c; if (q >= 512) return false; const int bh = q >> 4, b = bh >> 2, hh = bh & 3; u.pm = q & 15; u.pn = 0; u.z = bh; u.row0 = b * SEQ + u.pm * 256; u.col0 = hh * 256;
        u.a = XQ + ((size_t)u.row0 * 1024 + hh * 256) * 2; u.b = KM + ((size_t)b * 256 * 1024 + hh * 256) * 2; return true; }
};
struct XpvOrder {
    const char* PB; const char* VT; int G, c;
    DI bool next(int i, pg::Unit& u) const { const int q = i * G + c; if (q >= 512) return false; const int bh = q >> 4, b = bh >> 2, hh = bh & 3; u.pm = q & 15; u.pn = 0; u.z = bh; u.row0 = b * SEQ + u.pm * 256; u.col0 = hh * 256;
        u.a = PB + ((size_t)u.row0 * 1024 + hh * 256) * 2; u.b = VT + ((size_t)b * 1024 + hh * 256) * 256 * 2; return true; }
};
struct MoeOrder {
    const char* A; const char* Bt; size_t astep, bstep, estride; int nM, nN, G, c; int tb[9];
    DI void init(const void* A_, const void* Bt_, int lda, int ldb, int N, size_t estride_, const unsigned* cntw, int G_, int c_) { A = (const char*)A_; Bt = (const char*)Bt_; astep = (size_t)256 * lda * 2; bstep = (size_t)256 * ldb * 2; estride = estride_; nN = N / 256; G = G_; c = c_;
        int acc = 0;
#pragma unroll
        for (int e = 0; e < 8; ++e) { tb[e] = acc; acc += (int)((__builtin_amdgcn_readfirstlane(cntw[e * 64]) + 255u) >> 8); } tb[8] = acc; nM = acc; }
    DI bool next(int i, pg::Unit& u) const { if (!pg::tile_of(i, G, c, nM, nN, u.pm, u.pn)) return false; int e = 0;
#pragma unroll
        for (int k = 1; k < 8; ++k) e = u.pm >= tb[k] ? k : e;
        u.z = e; u.row0 = u.pm * 256; u.col0 = u.pn * 256; u.a = A + (size_t)u.pm * astep; u.b = Bt + (size_t)e * estride + (size_t)u.pn * bstep; return true; }
};
}
namespace fp {
constexpr int PH_PER_LAYER = 16, N_PHASES = 2 + NL * PH_PER_LAYER;

__global__ void __launch_bounds__(512, 2) fwd(Args args) {
    extern __shared__ __attribute__((aligned(16))) unsigned char lds_raw[];
    Ctx C0; Ctx& C_ = C0; C_.lds = (LAS unsigned char*)lds_raw;
    C_.tid = threadIdx.x; C_.lane = C_.tid & 63; C_.wave = __builtin_amdgcn_readfirstlane(C_.tid >> 6);
    C_.G = gridDim.x; { const int bx = blockIdx.x; C_.vcu = (C_.G % 8 == 0) ? (bx % 8) * (C_.G / 8) + bx / 8 : bx; }
    C_.gw = C_.vcu * 8 + C_.wave; C_.NGW = C_.G * 8; C_.gt = C_.vcu * 512 + C_.tid; C_.NGT = C_.G * 512;
    unsigned char* const ws0 = args.ws;
    unsigned* ctl = (unsigned*)(ws0 + WS_CTL);
    volatile LAS unsigned* lctl = (volatile LAS unsigned*)(C_.lds + LDS_CTL);
    if (C_.tid < 32) lctl[C_.tid] = 0u;
    __syncthreads();
    const int lo = args.ph_lo, hi = args.ph_hi;
    XcdBarrier bar; bar.bar = ctl + CW_BARBASE + args.bar_region * CW_BARSTRIDE; bar.x = 0; bar.st = lctl + 8;
    if (hi - lo > 1) bar = xcd_barrier_post(ctl + CW_BARBASE + args.bar_region * CW_BARSTRIDE, lctl + 8);
#ifndef PH_MASK
#define PH_MASK 0x3ffff
#endif
#define IN(k) (opaque_i(lo) <= (k) && (k) < opaque_i(hi))
#define INP(k) (((PH_MASK >> (16 + (k))) & 1) && IN(k))
#define INL(r) (((PH_MASK >> (r)) & 1) && IN(P + (r)))
#define SEAM(k) do { if (IN(k) && IN((k) + 1)) xcd_barrier(bar); } while (0)
    const int G0 = C_.G, cb0 = (int)blockIdx.x, vcu0 = C_.vcu;
    LAS unsigned char* lds = C_.lds;
#define PHASE_BEGIN unsigned char* ws = opaque_s(ws0); const int G = opaque_i(G0), cb = opaque_i(cb0); Ctx C; C.lds = lds; C.tid = opaque_v((int)threadIdx.x); C.lane = C.tid & 63; C.wave = __builtin_amdgcn_readfirstlane(C.tid >> 6); C.G = G; C.vcu = vcu0; C.gw = vcu0 * 8 + C.wave; C.NGW = G * 8; C.gt = vcu0 * 512 + C.tid; C.NGT = G * 512; (void)ws; (void)C;

    if (INP(0)) { PHASE_BEGIN prologue_a(C, args); }
    SEAM(0);
    if (INP(1)) { PHASE_BEGIN
        prologue_b_tables(C, args);
        KvOrder S{(const char*)(ws + WS_MEMB), (const char*)(ws + WS_WKV), G, cb};
        EpiKv E{(bf16_t*)(ws + WS_KM), (bf16_t*)(ws + WS_VT)};
        pg::gemm_phase<EpiKv, KvOrder, false>(lds, pg::Shape{1024, 1024, 1024}, S, E);
    }
    SEAM(1);

    for (int L = 0; L < NL; ++L) {
        const int P = 2 + L * PH_PER_LAYER, j2 = L >> 1; const bool moe = (L & 1) != 0;
        unsigned* moecnt = ctl + CW_MOECNT + L * 1024;
#define LAYER_PTRS const float* Xres = (L == 0) ? args.in[0] : (const float*)(ws + WS_XF); float* XF = (float*)(ws + WS_XF); bf16_t* XB = (bf16_t*)(ws + WS_XB); float* T = (float*)(ws + WS_T); (void)Xres; (void)XF; (void)XB; (void)T;
        if (INL(0)) { PHASE_BEGIN LAYER_PTRS
            pg::PlainOrder S; S.init(XB, ws + WS_WIN + (size_t)L * SZ_WIN, NTOK, INW, 1024, 1024, G, cb);
            EpiInProj E{(bf16_t*)(ws + WS_Q), (bf16_t*)(ws + WS_KK), (bf16_t*)(ws + WS_VV), (bf16_t*)(ws + WS_U), (bf16_t*)(ws + WS_UP), (bf16_t*)(ws + WS_GT), args.in[3] + (size_t)L * 3072, (const float*)(ws + WS_ROPE)};
            pg::gemm_phase<EpiInProj, pg::PlainOrder, true>(lds, pg::Shape{1024, 1024, 1024}, S, E);
        }
        SEAM(P + 0);
        if (INL(1)) { PHASE_BEGIN LAYER_PTRS
#ifndef SUB_MASK
#define SUB_MASK 7
#endif
            if (SUB_MASK & 1) swa_phase(C, (const bf16_t*)(ws + WS_Q), (const bf16_t*)(ws + WS_KK), (const bf16_t*)(ws + WS_VV), args.in[4] + L * 8, (bf16_t*)(ws + WS_ATTNO));
            if (SUB_MASK & 2) pool_phase(C, (const bf16_t*)(ws + WS_UP), (bf16_t*)(ws + WS_POOLED));
            __syncthreads();
            if (SUB_MASK & 4) {
            SsmEOrder S{(const char*)(ws + WS_U), (const char*)(ws + WS_PT + (size_t)L * SZ_PT), G, cb};
            EpiSsmE E{(bf16_t*)(ws + WS_U), (const float*)(ws + WS_PWR + (size_t)L * SZ_PWR)};
            pg::gemm_phase<EpiSsmE, SsmEOrder, false>(lds, pg::Shape{512, 640, 512}, S, E);
            }
        }
        SEAM(P + 1);
        if (INL(2)) { PHASE_BEGIN LAYER_PTRS
            { SsmYOrder S{(const char*)(ws + WS_U), (const char*)(ws + WS_MT + (size_t)L * SZ_MT), G, cb};
              EpiSsmY E{(bf16_t*)(ws + WS_YG)};
              pg::gemm_phase<EpiSsmY, SsmYOrder, false>(lds, pg::Shape{640, 640, 640}, S, E); }
            { pg::PlainOrder S; S.init(ws + WS_POOLED, ws + WS_WPOOL + (size_t)L * SZ_WPOOL, NTOK, 512, 512, 512, G, cb);
              EpiColScale E{(bf16_t*)(ws + WS_MIXED), 512, args.in[15] + (size_t)L * 512};
              pg::gemm_phase<EpiColScale, pg::PlainOrder, false>(lds, pg::Shape{512, 512, 512}, S, E); }
        }
        SEAM(P + 2);
        if (INL(3)) { PHASE_BEGIN LAYER_PTRS
            pg::PlainOrder S; S.init(ws + WS_YG, ws + WS_WGLU + (size_t)L * SZ_WGLU, NTOK, 1024, 512, 512, G, cb);
            EpiGlu<0> E{(bf16_t*)(ws + WS_SSMH), 512};
            pg::gemm_phase<EpiGlu<0>, pg::PlainOrder, true>(lds, pg::Shape{512, 512, 512}, S, E);
        }
        SEAM(P + 3);
        if (INL(4)) { PHASE_BEGIN LAYER_PTRS
            const bf16_t* GT = (const bf16_t*)(ws + WS_GT); bf16_t* MG = (bf16_t*)(ws + WS_MERGED);
            const unsigned char* wbr = ws + WS_WBR + (size_t)L * 3 * SZ_WBR;
            { pg::PlainOrder S; S.init(ws + WS_ATTNO, wbr, NTOK, 1024, 512, 512, G, cb); EpiBranch<false> E{GT, MG, 0};
              pg::gemm_phase<EpiBranch<false>, pg::PlainOrder, true>(lds, pg::Shape{512, 512, 512}, S, E); }
            asm volatile("s_waitcnt vmcnt(0)" ::: "memory"); __syncthreads(); __builtin_amdgcn_fence(__ATOMIC_ACQUIRE, "agent"); asm volatile("s_waitcnt vmcnt(0)" ::: "memory"); __syncthreads();
            { pg::PlainOrder S; S.init(ws + WS_SSMH, wbr + SZ_WBR, NTOK, 1024, 512, 512, G, cb); EpiBranch<true> E{GT, MG, 1};
              pg::gemm_phase<EpiBranch<true>, pg::PlainOrder, true>(lds, pg::Shape{512, 512, 512}, S, E); }
            asm volatile("s_waitcnt vmcnt(0)" ::: "memory"); __syncthreads(); __builtin_amdgcn_fence(__ATOMIC_ACQUIRE, "agent"); asm volatile("s_waitcnt vmcnt(0)" ::: "memory"); __syncthreads();
            { pg::PlainOrder S; S.init(ws + WS_MIXED, wbr + 2 * SZ_WBR, NTOK, 1024, 512, 512, G, cb); EpiBranch<true> E{GT, MG, 2};
              pg::gemm_phase<EpiBranch<true>, pg::PlainOrder, true>(lds, pg::Shape{512, 512, 512}, S, E); }
        }
        SEAM(P + 4);
        if (INL(5)) { PHASE_BEGIN LAYER_PTRS
            pg::PlainOrder S; S.init(ws + WS_MERGED, ws + WS_WO + (size_t)L * SZ_WSQ, NTOK, 1024, 1024, 1024, G, cb);
            EpiResid E{Xres, T};
            pg::gemm_phase<EpiResid, pg::PlainOrder, true>(lds, pg::Shape{1024, 1024, 1024}, S, E);
        }
        SEAM(P + 5);
        if (INL(6)) { PHASE_BEGIN LAYER_PTRS ln_phase<0, false>(C, T, nullptr, args.in[20] + L * 1024, args.in[21] + L * 1024, XF, XB, nullptr, nullptr, nullptr, nullptr, nullptr, nullptr, nullptr, nullptr, nullptr, nullptr, nullptr, nullptr); }
        SEAM(P + 6);
        if (INL(7)) { PHASE_BEGIN LAYER_PTRS
            pg::PlainOrder S; S.init(XB, ws + WS_WQ + (size_t)L * SZ_WSQ, NTOK, 1024, 1024, 1024, G, cb);
            EpiBf16 E{(bf16_t*)(ws + WS_XQ), 1024, XQSCALE};
            pg::gemm_phase<EpiBf16, pg::PlainOrder, true>(lds, pg::Shape{1024, 1024, 1024}, S, E);
        }
        SEAM(P + 7);
        if (INL(8)) { PHASE_BEGIN LAYER_PTRS
            XsOrder S{(const char*)(ws + WS_XQ), (const char*)(ws + WS_KM + (size_t)L * SZ_KM), G, cb};
            EpiSexp E{(bf16_t*)(ws + WS_PB), (float*)(ws + WS_RS)};
            pg::gemm_phase<EpiSexp, XsOrder, true>(lds, pg::Shape{256, 1024, 1024}, S, E);
        }
        SEAM(P + 8);
        if (INL(9)) { PHASE_BEGIN LAYER_PTRS
            XpvOrder S{(const char*)(ws + WS_PB), (const char*)(ws + WS_VT + (size_t)L * SZ_VT), G, cb};
            EpiPv E{(bf16_t*)(ws + WS_XO), (const float*)(ws + WS_RS)};
            pg::gemm_phase<EpiPv, XpvOrder, true>(lds, pg::Shape{256, 1024, 256}, S, E);
        }
        SEAM(P + 9);
        if (INL(10)) { PHASE_BEGIN LAYER_PTRS
            pg::PlainOrder S; S.init(ws + WS_XO, ws + WS_WXO + (size_t)L * SZ_WSQ, NTOK, 1024, 1024, 1024, G, cb);
            EpiResid E{XF, T};
            pg::gemm_phase<EpiResid, pg::PlainOrder, true>(lds, pg::Shape{1024, 1024, 1024}, S, E);
        }
        SEAM(P + 10);
        if (INL(11)) { PHASE_BEGIN LAYER_PTRS
            if (!moe) ln_phase<0, false>(C, T, nullptr, args.in[25] + L * 1024, args.in[26] + L * 1024, XF, XB, nullptr, nullptr, nullptr, nullptr, nullptr, nullptr, nullptr, nullptr, nullptr, nullptr, nullptr, nullptr);
            else ln_phase<0, true>(C, T, nullptr, args.in[25] + L * 1024, args.in[26] + L * 1024, XF, XB, nullptr, nullptr, nullptr, nullptr,
                                   args.in[29] + (size_t)j2 * 8192, args.in[30] + j2 * 8, (int*)(ws + WS_RTE), (int*)(ws + WS_RTP), (float*)(ws + WS_RTW), (int*)(ws + WS_SRC), (float*)(ws + WS_WL), moecnt);
        }
        SEAM(P + 11);
        if (INL(12)) { PHASE_BEGIN LAYER_PTRS if (moe) moe_gather_phase(C, moecnt, (const int*)(ws + WS_SRC), (const float*)(ws + WS_WL), XB, (bf16_t*)(ws + WS_XG), (float*)(ws + WS_WSLOT)); }
        SEAM(P + 12);
        if (INL(13)) { PHASE_BEGIN LAYER_PTRS
            if (!moe) { pg::PlainOrder S; S.init(XB, ws + WS_WGU + (size_t)j2 * SZ_WGU, NTOK, 2 * DFF, 1024, 1024, G, cb);
                EpiGlu<1> E{(bf16_t*)(ws + WS_H), DFF};
                pg::gemm_phase<EpiGlu<1>, pg::PlainOrder, true>(lds, pg::Shape{1024, 1024, 1024}, S, E); }
            else { MoeOrder S; S.init(ws + WS_XG, ws + WS_MGU + (size_t)j2 * NE * SZ_MGU, 1024, 1024, 2 * DFFE, SZ_MGU, moecnt, G, cb);
                EpiGlu<1> E{(bf16_t*)(ws + WS_H), DFFE};
                pg::gemm_phase<EpiGlu<1>, MoeOrder, true>(lds, pg::Shape{1024, 1024, 1024}, S, E); }
        }
        SEAM(P + 13);
        if (INL(14)) { PHASE_BEGIN LAYER_PTRS
            if (!moe) { pg::PlainOrder S; S.init(ws + WS_H, ws + WS_WDN + (size_t)j2 * SZ_WDN, NTOK, 1024, DFF, DFF, G, cb);
                EpiResid E{XF, T};
                pg::gemm_phase<EpiResid, pg::PlainOrder, true>(lds, pg::Shape{DFF, DFF, DFF}, S, E); }
            else { MoeOrder S; S.init(ws + WS_H, ws + WS_MDN + (size_t)j2 * NE * SZ_MDN, DFFE, DFFE, 1024, SZ_MDN, moecnt, G, cb);
                EpiMoeDown E{(bf16_t*)(ws + WS_XG), (const float*)(ws + WS_WSLOT)};
                pg::gemm_phase<EpiMoeDown, MoeOrder, true>(lds, pg::Shape{DFFE, DFFE, DFFE}, S, E); }
        }
        SEAM(P + 14);
        if (INL(15)) { PHASE_BEGIN LAYER_PTRS
            float* xo = (L == NL - 1) ? args.out : XF;
            if (!moe) ln_phase<0, false>(C, T, nullptr, args.in[33] + L * 1024, args.in[34] + L * 1024, xo, XB, nullptr, nullptr, nullptr, nullptr, nullptr, nullptr, nullptr, nullptr, nullptr, nullptr, nullptr, nullptr);
            else ln_phase<1, false>(C, nullptr, XF, args.in[33] + L * 1024, args.in[34] + L * 1024, xo, XB, (const bf16_t*)(ws + WS_XG), (const int*)(ws + WS_RTE), (const int*)(ws + WS_RTP), moecnt, nullptr, nullptr, nullptr, nullptr, nullptr, nullptr, nullptr, nullptr);
        }
        SEAM(P + 15);
    }
#undef IN
#undef PHASE_BEGIN
#undef LAYER_PTRS
#undef INP
#undef INL
#undef SEAM
}
}
#ifndef BUILD_MODE
#define BUILD_MODE 0
#endif
#ifndef DBG_BASE
#define DBG_BASE 0
#endif
#if BUILD_MODE == 2
namespace dbg {
constexpr int DBG_R = 4096;
struct CmpP { const float* ref; const void* test; const float* bias; float* err; int rows, cols, ldr, rcoff, ldt, tcoff, mode, id, refop, pad; float rscale; int pad2; };
__global__ void cmp_k(CmpP p) {
    float num = 0.f, den = 0.f; const long long n = (long long)p.rows * p.cols;
    for (long long idx = (long long)blockIdx.x * blockDim.x + threadIdx.x; idx < n; idx += (long long)gridDim.x * blockDim.x) {
        const int row = (int)(idx / p.cols), c = (int)(idx % p.cols);
        float r = p.ref[(size_t)row * p.ldr + p.rcoff + c];
        r = p.refop == 1 ? 1.f / (1.f + expf(-(r + p.bias[c]))) : r * p.rscale;
        float t;
        if (p.mode == 0) t = bf2f(((const bf16_t*)p.test)[(size_t)row * p.ldt + p.tcoff + c]);
        else if (p.mode == 1) t = ((const float*)p.test)[(size_t)row * p.ldt + p.tcoff + c];
        else t = bf2f(((const bf16_t*)p.test)[(size_t)(c >> 4) * fp::UG_STRIDE + (size_t)(row >> 5) * 640 + (row & 31) * 16 + (c & 15)]);
        const float d = r - t; num += d * d; den += r * r;
        if (!(t - t == 0.f)) num += 1.0e30f;
    }
    num = wave_sum(num); den = wave_sum(den);
    if ((threadIdx.x & 63) == 0) { atomicAdd(p.err + 2 * p.id, num); atomicAdd(p.err + 2 * p.id + 1, den); }
}
__global__ void cmp_route_k(const int* tope_ref, const int* rte, float* err, int id, int R) {
    float bad = 0.f;
    for (int row = blockIdx.x * blockDim.x + threadIdx.x; row < R; row += gridDim.x * blockDim.x) bad += (tope_ref[row * 2] != rte[row * 2] || tope_ref[row * 2 + 1] != rte[row * 2 + 1]) ? 1.f : 0.f;
    bad = wave_sum(bad);
    if ((threadIdx.x & 63) == 0) atomicAdd(err + 2 * id, bad);
    if (blockIdx.x == 0 && threadIdx.x == 0) atomicAdd(err + 2 * id + 1, (float)R * 20.f);
}
__global__ void decide_k(const float* err, int nchecks, float tol, int base, int* code) {
    if (threadIdx.x == 0 && blockIdx.x == 0) { int c = 0;
        for (int i = 0; i < nchecks; ++i) { const float num = err[2 * i], den = err[2 * i + 1]; const bool bad = !(num <= tol * den) || !(den > 0.f); if (bad) { c = i - base + 1; if (c < 1) c = 1; if (c > 28) c = 28; break; } }
        *code = c; }
}
__global__ void sign_k(float* out, const float* xn, const int* code, int R) {
    const float k = 1.f + (float)(*code);
    for (long long i = (long long)blockIdx.x * blockDim.x + threadIdx.x; i < (long long)fp::NTOK * 1024; i += (long long)gridDim.x * blockDim.x) out[i] = i < (long long)R * 1024 ? xn[i] * k : 0.f;
}
}
#endif

extern "C" void kernel_launch(void* const* d_in, const int* in_sizes, int n_in, void* d_out, int out_size, void* d_ws, size_t ws_size, hipStream_t stream) {
    (void)in_sizes; (void)n_in; (void)out_size;
    static int grid = 0;
    if (grid == 0) {
        int dev = 0, cus = 0;
        if (hipGetDevice(&dev) != hipSuccess || hipDeviceGetAttribute(&cus, hipDeviceAttributeMultiprocessorCount, dev) != hipSuccess) { fprintf(stderr, "kernel_launch: device query failed\n"); grid = -1; return; }
        if (hipFuncSetAttribute((const void*)fp::fwd, hipFuncAttributeMaxDynamicSharedMemorySize, fp::LDS_BYTES) != hipSuccess) { fprintf(stderr, "kernel_launch: hipFuncSetAttribute failed\n"); grid = -1; return; }
        int per_cu = 0; (void)hipOccupancyMaxActiveBlocksPerMultiprocessor(&per_cu, (const void*)fp::fwd, 512, fp::LDS_BYTES); (void)hipGetLastError();
        grid = cus;
        if (ws_size < fp::WS_FAST_END2) { fprintf(stderr, "kernel_launch: workspace too small (%zu < %zu)\n", ws_size, (size_t)fp::WS_FAST_END2); grid = -1; return; }
    }
    if (grid < 0) return;
    (void)hipMemsetAsync((char*)d_ws + fp::WS_CTL, 0, fp::CTL_BYTES, stream);
    fp::Args a; memset(&a, 0, sizeof(a));
    for (int i = 0; i < 35; ++i) a.in[i] = (const float*)d_in[i];
    a.out = (float*)d_out; a.ws = (unsigned char*)d_ws;
    auto run = [&](int lo, int hi, int region) { a.ph_lo = lo; a.ph_hi = hi; a.bar_region = region; hipLaunchKernelGGL(fp::fwd, dim3(grid), dim3(512), fp::LDS_BYTES, stream, a); };
#if BUILD_MODE == 0
    run(0, fp::N_PHASES, 0);
#elif BUILD_MODE == 1
    for (int p = 0; p < fp::N_PHASES; ++p) run(p, p + 1, 0);
#else
    using namespace dbg;
    unsigned char* ws = (unsigned char*)d_ws;
    float* err = (float*)(ws + fp::WS_CTL) + fp::CW_ERR; int* code = (int*)(err + 512);
    nv::Naive N; N.st = stream; N.in = d_in; N.carve(ws + fp::WS_FAST_END2, DBG_R, 1);
    int nchk = 0;
    auto cmp = [&](const float* ref, int ldr, int rcoff, float rscale, const void* test, int ldt, int tcoff, int mode, int cols, int refop = 0, const float* bias = nullptr) {
        CmpP p; memset(&p, 0, sizeof(p)); p.ref = ref; p.test = test; p.bias = bias; p.err = err; p.rows = DBG_R; p.cols = cols; p.ldr = ldr; p.rcoff = rcoff; p.ldt = ldt; p.tcoff = tcoff; p.mode = mode; p.id = nchk++; p.refop = refop; p.rscale = rscale;
        hipLaunchKernelGGL(cmp_k, dim3(512), dim3(256), 0, stream, p); };
    run(0, 1, 0); run(1, 2, 0);
    const float* Xn = (const float*)d_in[0]; float* nb[2] = {N.XA, N.XB}; int cur = 0;
    for (int L = 0; L < 4; ++L) {
        const int P = 2 + L * fp::PH_PER_LAYER;
        N.mixer_proj(L, Xn); run(P, P + 1, 0);
        cmp(N.PROJ, nv::INW, 0, fp::QSCALE, ws + fp::WS_Q, 512, 0, 0, 512);
        cmp(N.PROJ, nv::INW, 512, 1.f, ws + fp::WS_KK, 128, 0, 0, 128);
        cmp(N.PROJ, nv::INW, 640, 1.f, ws + fp::WS_VV, 128, 0, 0, 128);
        cmp(N.PROJ, nv::INW, 768, 1.f, ws + fp::WS_U, 0, 0, 2, 512);
        cmp(N.PROJ, nv::INW, 1280, 1.f, ws + fp::WS_UP, 512, 0, 0, 512);
        cmp(N.PROJ, nv::INW, 1792, 1.f, ws + fp::WS_GT, 3072, 0, 0, 3072, 1, (const float*)d_in[3] + (size_t)L * 3072);
        N.mixer_attn(L); N.mixer_ssm(L); N.mixer_pool(L); run(P + 1, P + 2, 0); run(P + 2, P + 3, 0); run(P + 3, P + 4, 0);
        cmp(N.ATTNO, 512, 0, 1.f, ws + fp::WS_ATTNO, 512, 0, 0, 512);
        cmp(N.POOLED, 512, 0, 1.f, ws + fp::WS_POOLED, 512, 0, 0, 512);
        cmp(N.YG, 512, 0, 1.f, ws + fp::WS_YG, 512, 0, 0, 512);
        cmp(N.MIXED, 512, 0, 1.f, ws + fp::WS_MIXED, 512, 0, 0, 512);
        cmp(N.SSMH, 512, 0, 1.f, ws + fp::WS_SSMH, 512, 0, 0, 512);
        N.mixer_merge(L); run(P + 4, P + 5, 0);
        cmp(N.MERGED, 1024, 0, 1.f, ws + fp::WS_MERGED, 1024, 0, 0, 1024);
        float* X1 = nb[cur]; cur ^= 1; N.mixer_out(L, Xn, X1); run(P + 5, P + 6, 0); run(P + 6, P + 7, 0);
        cmp(X1, 1024, 0, 1.f, ws + fp::WS_XF, 1024, 0, 1, 1024);
        N.xattn_qkv(L, X1); run(P + 7, P + 8, 0);
        cmp(N.Q, 1024, 0, fp::XQSCALE, ws + fp::WS_XQ, 1024, 0, 0, 1024);
        N.xattn_core(); run(P + 8, P + 9, 0); run(P + 9, P + 10, 0);
        cmp(N.XO, 1024, 0, 1.f, ws + fp::WS_XO, 1024, 0, 0, 1024);
        float* X2 = nb[cur]; cur ^= 1; N.xattn_out(L, X1, X2); run(P + 10, P + 11, 0); run(P + 11, P + 12, 0);
        cmp(X2, 1024, 0, 1.f, ws + fp::WS_XF, 1024, 0, 1, 1024);
        float* X3 = nb[cur]; cur ^= 1;
        if ((L & 1) == 0) { N.ffn_dense(L, X2, X3); run(P + 12, P + 13, 0); run(P + 13, P + 14, 0);
            cmp(N.H, fp::DFF, 0, 1.f, ws + fp::WS_H, fp::DFF, 0, 0, fp::DFF);
        } else { N.ffn_moe_route(L, X2); N.ffn_moe(L, X2, X3); run(P + 12, P + 13, 0); run(P + 13, P + 14, 0);
            hipLaunchKernelGGL(cmp_route_k, dim3(64), dim3(256), 0, stream, (const int*)N.tope, (const int*)(ws + fp::WS_RTE), err, nchk++, DBG_R); }
        run(P + 14, P + 15, 0); run(P + 15, P + 16, 0);
        cmp(X3, 1024, 0, 1.f, (L == 3) ? (const void*)d_out : (const void*)(ws + fp::WS_XF), 1024, 0, 1, 1024);
        Xn = X3;
    }
    hipLaunchKernelGGL(decide_k, dim3(1), dim3(64), 0, stream, (const float*)err, nchk, 2.0e-3f, (int)DBG_BASE, code);
    hipLaunchKernelGGL(sign_k, dim3(2048), dim3(256), 0, stream, (float*)d_out, Xn, (const int*)code, DBG_R);
#endif
}
```
